# Optimizing an MI355X kernel written in HIP

```python
import math
import jax
import jax.numpy as jnp
from jax import lax
import numpy as np

D_MODEL = 2048
BATCH = 8
SEQ = 4096
DEPTH = 2

GRID_W = 64
CTX_LEN = 256
HEAD_DIM = 128
GROUP_WIDTH = 512
N_GROUPS = 4
MIX_WIDTH = N_GROUPS * GROUP_WIDTH
GQA_HEADS = 4
GQA_KV_HEADS = 2
DIFF_HEADS = 4
DIFF_QK_DIM = 64
DIFF_V_DIM = 128
WIN_HEADS = 4
WIN_KV_HEADS = 2
WINDOW = 128
MLA_HEADS = 4
MLA_Q_RANK = 512
MLA_KV_RANK = 256
MLA_NOPE = 128
MLA_ROPE = 64
MLA_V = 128
MLA_QK_DIM = MLA_NOPE + MLA_ROPE
D_FF = ((8 * D_MODEL + 3 * 256 - 1) // (3 * 256)) * 256
Q_BLOCK = 128
N_NBR = (WINDOW + Q_BLOCK - 1) // Q_BLOCK
BAND = (2 * N_NBR + 1) * Q_BLOCK
ROPE_BASE = 10000.0
NORM_EPS = 1e-6
NEG_INF = -1e30
IN_SPLITS = (
    GQA_HEADS * HEAD_DIM, GQA_KV_HEADS * HEAD_DIM, GQA_KV_HEADS * HEAD_DIM,
    DIFF_HEADS * 2 * DIFF_QK_DIM, DIFF_HEADS * 2 * DIFF_QK_DIM, DIFF_HEADS * DIFF_V_DIM,
    WIN_HEADS * HEAD_DIM, WIN_KV_HEADS * HEAD_DIM, WIN_KV_HEADS * HEAD_DIM,
    MLA_Q_RANK, MLA_KV_RANK, MLA_ROPE,
)
IN_COLS = sum(IN_SPLITS)

kernel_name = 'hybrid_parallel_heads_flow_block'


def rmsnorm(x, g):
    xf = x.astype(jnp.float32)
    y = xf * lax.rsqrt(jnp.mean(xf * xf, axis=-1, keepdims=True) + NORM_EPS)
    return (y * g.astype(jnp.float32)).astype(x.dtype)


def modulate(h, shift, scale):
    return h * (1.0 + scale) + shift


def softmax_f32(s):
    return jax.nn.softmax(s.astype(jnp.float32), axis=-1)


def axial_rope_tables(n_tokens, dim):
    rows = n_tokens // GRID_W
    row = jnp.broadcast_to(jnp.arange(rows)[:, None], (rows, GRID_W)).reshape(-1).astype(jnp.float32)
    col = jnp.broadcast_to(jnp.arange(GRID_W)[None, :], (rows, GRID_W)).reshape(-1).astype(jnp.float32)
    quarter = dim // 4
    inv_freq = ROPE_BASE ** (-jnp.arange(quarter, dtype=jnp.float32) / quarter)
    ang = jnp.concatenate([row[:, None] * inv_freq, col[:, None] * inv_freq], axis=-1)
    return jnp.cos(ang), jnp.sin(ang)


def apply_rope(x, rope):
    cos, sin = rope
    shape = (cos.shape[0],) + (1,) * (x.ndim - 3) + (cos.shape[1],)
    cos, sin = cos.reshape(shape), sin.reshape(shape)
    xf = x.astype(jnp.float32)
    half = x.shape[-1] // 2
    x1, x2 = xf[..., :half], xf[..., half:]
    return jnp.concatenate([x1 * cos - x2 * sin, x2 * cos + x1 * sin], axis=-1).astype(x.dtype)


def split_columns(y):
    offsets = []
    acc = 0
    for w in IN_SPLITS[:-1]:
        acc += w
        offsets.append(acc)
    return jnp.split(y, offsets, axis=-1)


def to_blocks(a):
    b, t = a.shape[:2]
    return jnp.moveaxis(a.reshape(b, t // Q_BLOCK, Q_BLOCK, *a.shape[2:]), 1, 0)


def from_blocks(a):
    nb, b = a.shape[:2]
    return jnp.moveaxis(a, 0, 1).reshape(b, nb * Q_BLOCK, *a.shape[3:])


def sweep_query_blocks(block_fn, *qs):
    return from_blocks(lax.map(block_fn, tuple(to_blocks(q) for q in qs)))


def dense_gqa(q, k, v, scale):
    def block(args):
        (qb,) = args
        s = jnp.einsum('bqgrd,bkgd->bgrqk', qb, k) * scale
        p = softmax_f32(s).astype(v.dtype)
        return jnp.einsum('bgrqk,bkge->bqgre', p, v)
    o = sweep_query_blocks(block, q)
    return o.reshape(o.shape[0], o.shape[1], -1)


def diff_attention(q1, q2, k1, k2, v, lam, scale):
    def block(args):
        q1b, q2b = args
        p1 = softmax_f32(jnp.einsum('bqhd,bkhd->bhqk', q1b, k1) * scale)
        p2 = softmax_f32(jnp.einsum('bqhd,bkhd->bhqk', q2b, k2) * scale)
        return jnp.einsum('bhqk,bkhe->bqhe', (p1 - lam * p2).astype(v.dtype), v)
    return sweep_query_blocks(block, q1, q2)


def sink_attention_block(qb, k, v, sink, scale, mask):
    s = jnp.einsum('bqgrd,bkgd->bgrqk', qb, k).astype(jnp.float32) * scale
    if mask is not None:
        s = jnp.where(mask, s, NEG_INF)
    sink_col = jnp.broadcast_to(sink.astype(jnp.float32)[None, :, :, None, None], s.shape[:-1] + (1,))
    p = softmax_f32(jnp.concatenate([s, sink_col], axis=-1))[..., :-1]
    return jnp.einsum('bgrqk,bkge->bqgre', p.astype(v.dtype), v)


def windowed_sink_attention(q, k, v, k_ctx, v_ctx, sink, scale):
    b, t = q.shape[:2]
    nb = t // Q_BLOCK
    pad = N_NBR * Q_BLOCK

    def band(a):
        ap = jnp.pad(a, ((0, 0), (pad, pad), (0, 0), (0, 0)))
        ab = ap.reshape(b, nb + 2 * N_NBR, Q_BLOCK, *a.shape[2:])
        banded = jnp.concatenate([ab[:, j:j + nb] for j in range(2 * N_NBR + 1)], axis=2)
        return jnp.moveaxis(banded, 1, 0)

    blk = jnp.arange(nb)[:, None, None]
    q_pos = blk * Q_BLOCK + jnp.arange(Q_BLOCK)[None, :, None]
    k_pos = (blk - N_NBR) * Q_BLOCK + jnp.arange(BAND)[None, None, :]
    band_mask = (jnp.abs(q_pos - k_pos) <= WINDOW) & (k_pos >= 0) & (k_pos < t)
    ctx_mask = jnp.ones((Q_BLOCK, k_ctx.shape[1]), dtype=bool)

    def block(args):
        qb, kb, vb, mb = args
        keys = jnp.concatenate([k_ctx, kb], axis=1)
        vals = jnp.concatenate([v_ctx, vb], axis=1)
        return sink_attention_block(qb, keys, vals, sink, scale, jnp.concatenate([ctx_mask, mb], axis=-1))

    o = from_blocks(lax.map(block, (to_blocks(q), band(k), band(v), band_mask)))
    return o.reshape(b, t, -1)


def mixer_gqa(q, k, v, qc, kc, vc, q_gain, k_gain, rope, need_ctx_out):
    rep = GQA_HEADS // GQA_KV_HEADS
    scale = HEAD_DIM ** -0.5

    def prep(q, k, v, rotate):
        b, t = q.shape[:2]
        q = rmsnorm(q.reshape(b, t, GQA_HEADS, HEAD_DIM), q_gain)
        k = rmsnorm(k.reshape(b, t, GQA_KV_HEADS, HEAD_DIM), k_gain)
        if rotate:
            q, k = apply_rope(q, rope), apply_rope(k, rope)
        return q.reshape(b, t, GQA_KV_HEADS, rep, HEAD_DIM), k, v.reshape(b, t, GQA_KV_HEADS, HEAD_DIM)

    q, k, v = prep(q, k, v, True)
    qc, kc, vc = prep(qc, kc, vc, False)
    out = dense_gqa(q, jnp.concatenate([kc, k], axis=1), jnp.concatenate([vc, v], axis=1), scale)
    out_c = dense_gqa(qc, kc, vc, scale) if need_ctx_out else None
    return out, out_c


def mixer_diff(q, k, v, qc, kc, vc, lq1, lk1, lq2, lk2, subln, lam_init, rope, need_ctx_out):
    scale = DIFF_QK_DIM ** -0.5
    f32 = jnp.float32
    lam = (jnp.exp(jnp.sum(lq1.astype(f32) * lk1.astype(f32)))
           - jnp.exp(jnp.sum(lq2.astype(f32) * lk2.astype(f32))) + lam_init)

    def prep(q, k, v, rotate):
        b, t = q.shape[:2]
        q = q.reshape(b, t, DIFF_HEADS, 2, DIFF_QK_DIM)
        k = k.reshape(b, t, DIFF_HEADS, 2, DIFF_QK_DIM)
        q1, q2, k1, k2 = q[:, :, :, 0], q[:, :, :, 1], k[:, :, :, 0], k[:, :, :, 1]
        if rotate:
            q1, q2, k1, k2 = (apply_rope(a, rope) for a in (q1, q2, k1, k2))
        return q1, q2, k1, k2, v.reshape(b, t, DIFF_HEADS, DIFF_V_DIM)

    def finish(o):
        o = rmsnorm(o, subln) * (1.0 - lam_init)
        return o.reshape(o.shape[0], o.shape[1], -1)

    q1, q2, k1, k2, v = prep(q, k, v, True)
    q1c, q2c, k1c, k2c, vc = prep(qc, kc, vc, False)
    out = diff_attention(q1, q2, jnp.concatenate([k1c, k1], axis=1), jnp.concatenate([k2c, k2], axis=1),
                         jnp.concatenate([vc, v], axis=1), lam, scale)
    out_c = finish(diff_attention(q1c, q2c, k1c, k2c, vc, lam, scale)) if need_ctx_out else None
    return finish(out), out_c


def mixer_window(q, k, v, qc, kc, vc, sinks, rope, need_ctx_out):
    rep = WIN_HEADS // WIN_KV_HEADS
    scale = HEAD_DIM ** -0.5
    sink = sinks.reshape(WIN_KV_HEADS, rep)

    def prep(q, k, v, rotate):
        b, t = q.shape[:2]
        q = q.reshape(b, t, WIN_HEADS, HEAD_DIM)
        k = k.reshape(b, t, WIN_KV_HEADS, HEAD_DIM)
        if rotate:
            q, k = apply_rope(q, rope), apply_rope(k, rope)
        return q.reshape(b, t, WIN_KV_HEADS, rep, HEAD_DIM), k, v.reshape(b, t, WIN_KV_HEADS, HEAD_DIM)

    q, k, v = prep(q, k, v, True)
    qc, kc, vc = prep(qc, kc, vc, False)
    out = windowed_sink_attention(q, k, v, kc, vc, sink, scale)
    out_c = None
    if need_ctx_out:
        oc = sink_attention_block(qc, kc, vc, sink, scale, None)
        out_c = oc.reshape(oc.shape[0], oc.shape[1], -1)
    return out, out_c


def mixer_mla(cq, ckv, kr, cqc, ckvc, krc, q_norm, w_uq, kv_norm, w_ukv, rope, need_ctx_out):
    scale = MLA_QK_DIM ** -0.5

    def prep(cq, ckv, kr, rotate):
        b, t = cq.shape[:2]
        q = (rmsnorm(cq, q_norm) @ w_uq).reshape(b, t, MLA_HEADS, MLA_QK_DIM)
        kv = (rmsnorm(ckv, kv_norm) @ w_ukv).reshape(b, t, MLA_HEADS, MLA_NOPE + MLA_V)
        q_nope, q_rot = q[..., :MLA_NOPE], q[..., MLA_NOPE:]
        k_nope, v = kv[..., :MLA_NOPE], kv[..., MLA_NOPE:]
        if rotate:
            q_rot, kr = apply_rope(q_rot, rope), apply_rope(kr, rope)
        k_rot = jnp.broadcast_to(kr[:, :, None, :], (b, t, MLA_HEADS, MLA_ROPE))
        q = jnp.concatenate([q_nope, q_rot], axis=-1).reshape(b, t, MLA_HEADS, 1, MLA_QK_DIM)
        return q, jnp.concatenate([k_nope, k_rot], axis=-1), v

    q, k, v = prep(cq, ckv, kr, True)
    qc, kc, vc = prep(cqc, ckvc, krc, False)
    out = dense_gqa(q, jnp.concatenate([kc, k], axis=1), jnp.concatenate([vc, v], axis=1), scale)
    out_c = dense_gqa(qc, kc, vc, scale) if need_ctx_out else None
    return out, out_c


def swiglu(h, w_gate, w_up, w_down):
    return (jax.nn.silu(h @ w_gate) * (h @ w_up)) @ w_down


def trunk_layer(x, ctx, mod_lat, mod_ctx, lp, ropes, lam_init, need_ctx_out):
    rope_hd, rope_diff, rope_mla = ropes
    m = jnp.split(mod_lat, 6, axis=-1)
    mc = jnp.split(mod_ctx, 6, axis=-1)
    h = modulate(rmsnorm(x, lp['norm_pre_mix']), m[0], m[1])
    hc = modulate(rmsnorm(ctx, lp['norm_pre_mix']), mc[0], mc[1])
    p = split_columns(h @ lp['w_in'])
    pc = split_columns(hc @ lp['w_in'])
    a, ac = mixer_gqa(p[0], p[1], p[2], pc[0], pc[1], pc[2], lp['gqa_q_norm'], lp['gqa_k_norm'],
                      rope_hd, need_ctx_out)
    b, bc = mixer_diff(p[3], p[4], p[5], pc[3], pc[4], pc[5], lp['diff_lambda_q1'], lp['diff_lambda_k1'],
                       lp['diff_lambda_q2'], lp['diff_lambda_k2'], lp['diff_subln'], lam_init,
                       rope_diff, need_ctx_out)
    w, wc = mixer_window(p[6], p[7], p[8], pc[6], pc[7], pc[8], lp['win_sinks'], rope_hd, need_ctx_out)
    d, dc = mixer_mla(p[9], p[10], p[11], pc[9], pc[10], pc[11], lp['mla_q_norm'], lp['mla_w_uq'],
                      lp['mla_kv_norm'], lp['mla_w_ukv'], rope_mla, need_ctx_out)
    y = jnp.concatenate([a, b, w, d], axis=-1) @ lp['w_out']
    x = x + m[2] * rmsnorm(y, lp['norm_post_mix'])
    h = modulate(rmsnorm(x, lp['norm_pre_ffn']), m[3], m[4])
    x = x + m[5] * rmsnorm(swiglu(h, lp['ffn_w_gate'], lp['ffn_w_up'], lp['ffn_w_down']), lp['norm_post_ffn'])
    if need_ctx_out:
        yc = jnp.concatenate([ac, bc, wc, dc], axis=-1) @ lp['w_out']
        ctx = ctx + mc[2] * rmsnorm(yc, lp['norm_post_mix'])
        hc = modulate(rmsnorm(ctx, lp['norm_pre_ffn']), mc[3], mc[4])
        ctx = ctx + mc[5] * rmsnorm(swiglu(hc, lp['ffn_w_gate'], lp['ffn_w_up'], lp['ffn_w_down']),
                                    lp['norm_post_ffn'])
    return x, ctx


def setup_inputs(seed: int = 0) -> dict:
    key = jax.random.key(seed)
    ks = jax.random.split(key, 27)
    f32 = jnp.float32
    L = DEPTH

    def normal(k, shape, scale):
        return jax.random.normal(k, shape, f32) * scale

    def gain(k, shape):
        return 1.0 + 0.05 * jax.random.normal(k, shape, f32)

    return {
        'x': normal(ks[0], (BATCH, SEQ, D_MODEL), 1.0),
        'c': normal(ks[1], (BATCH, D_MODEL), 1.0),
        'ctx': normal(ks[2], (BATCH, CTX_LEN, D_MODEL), 1.0),
        'c_ctx': normal(ks[3], (D_MODEL,), 1.0),
        'ada_w': normal(ks[4], (L, D_MODEL, 6 * D_MODEL), 0.5 * D_MODEL ** -0.5),
        'ada_b': normal(ks[5], (L, 6 * D_MODEL), 0.01),
        'norm_pre_mix': gain(ks[6], (L, D_MODEL)),
        'norm_post_mix': gain(ks[7], (L, D_MODEL)),
        'norm_pre_ffn': gain(ks[8], (L, D_MODEL)),
        'norm_post_ffn': gain(ks[9], (L, D_MODEL)),
        'w_in': normal(ks[10], (L, D_MODEL, IN_COLS), D_MODEL ** -0.5),
        'gqa_q_norm': gain(ks[11], (L, HEAD_DIM)),
        'gqa_k_norm': gain(ks[12], (L, HEAD_DIM)),
        'diff_lambda_q1': normal(ks[13], (L, DIFF_QK_DIM), 0.1),
        'diff_lambda_k1': normal(ks[14], (L, DIFF_QK_DIM), 0.1),
        'diff_lambda_q2': normal(ks[15], (L, DIFF_QK_DIM), 0.1),
        'diff_lambda_k2': normal(ks[16], (L, DIFF_QK_DIM), 0.1),
        'diff_subln': gain(ks[17], (L, DIFF_V_DIM)),
        'win_sinks': normal(ks[18], (L, WIN_HEADS), 0.5),
        'mla_q_norm': gain(ks[19], (L, MLA_Q_RANK)),
        'mla_w_uq': normal(ks[20], (L, MLA_Q_RANK, MLA_HEADS * MLA_QK_DIM), MLA_Q_RANK ** -0.5),
        'mla_kv_norm': gain(ks[21], (L, MLA_KV_RANK)),
        'mla_w_ukv': normal(ks[22], (L, MLA_KV_RANK, MLA_HEADS * (MLA_NOPE + MLA_V)), MLA_KV_RANK ** -0.5),
        'w_out': normal(ks[23], (L, MIX_WIDTH, D_MODEL), MIX_WIDTH ** -0.5),
        'ffn_w_gate': normal(ks[24], (L, D_MODEL, D_FF), D_MODEL ** -0.5),
        'ffn_w_up': normal(ks[25], (L, D_MODEL, D_FF), D_MODEL ** -0.5),
        'ffn_w_down': normal(ks[26], (L, D_FF, D_MODEL), D_FF ** -0.5),
    }


def reference(x, c, ctx, c_ctx, ada_w, ada_b, norm_pre_mix, norm_post_mix, norm_pre_ffn, norm_post_ffn,
              w_in, gqa_q_norm, gqa_k_norm, diff_lambda_q1, diff_lambda_k1, diff_lambda_q2, diff_lambda_k2,
              diff_subln, win_sinks, mla_q_norm, mla_w_uq, mla_kv_norm, mla_w_ukv, w_out,
              ffn_w_gate, ffn_w_up, ffn_w_down):
    n_tokens = x.shape[1]
    ropes = (axial_rope_tables(n_tokens, HEAD_DIM), axial_rope_tables(n_tokens, DIFF_QK_DIM),
             axial_rope_tables(n_tokens, MLA_ROPE))
    silu_c = jax.nn.silu(c)
    silu_cc = jax.nn.silu(c_ctx)
    for l in range(DEPTH):
        mod_lat = (silu_c @ ada_w[l] + ada_b[l])[:, None, :]
        mod_ctx = (silu_cc @ ada_w[l] + ada_b[l])[None, None, :]
        lp = {
            'norm_pre_mix': norm_pre_mix[l], 'norm_post_mix': norm_post_mix[l],
            'norm_pre_ffn': norm_pre_ffn[l], 'norm_post_ffn': norm_post_ffn[l],
            'w_in': w_in[l], 'gqa_q_norm': gqa_q_norm[l], 'gqa_k_norm': gqa_k_norm[l],
            'diff_lambda_q1': diff_lambda_q1[l], 'diff_lambda_k1': diff_lambda_k1[l],
            'diff_lambda_q2': diff_lambda_q2[l], 'diff_lambda_k2': diff_lambda_k2[l],
            'diff_subln': diff_subln[l], 'win_sinks': win_sinks[l],
            'mla_q_norm': mla_q_norm[l], 'mla_w_uq': mla_w_uq[l],
            'mla_kv_norm': mla_kv_norm[l], 'mla_w_ukv': mla_w_ukv[l],
            'w_out': w_out[l], 'ffn_w_gate': ffn_w_gate[l], 'ffn_w_up': ffn_w_up[l],
            'ffn_w_down': ffn_w_down[l],
        }
        lam_init = 0.8 - 0.6 * math.exp(-0.3 * l)
        x, ctx = trunk_layer(x, ctx, mod_lat, mod_ctx, lp, ropes, lam_init, l < DEPTH - 1)
    return x
```

```cpp
#include <hip/hip_runtime.h>
#include <hip/hip_cooperative_groups.h>
#include <cstdio>
#include <cmath>
namespace cg = cooperative_groups;

typedef unsigned short bf16_t;
typedef short bf16x8 __attribute__((ext_vector_type(8)));
typedef short s16x4 __attribute__((ext_vector_type(4)));
typedef float f32x2 __attribute__((ext_vector_type(2)));
typedef float f32x4 __attribute__((ext_vector_type(4)));
typedef float f32x16 __attribute__((ext_vector_type(16)));
typedef unsigned u32x2 __attribute__((ext_vector_type(2)));
typedef unsigned u32x4 __attribute__((ext_vector_type(4)));
#define LAS __attribute__((address_space(3)))

constexpr int NLAT = 32768, NCTX = 2048, NROWS = NLAT + NCTX, DM = 2048, SEQ = 4096, CTXL = 256, NB = 8;
constexpr int INC = 4416, LDP = 4608, DFF = 5632, LDQM = 768, LDKVM = 1024;
constexpr float EPS = 1e-6f;
constexpr int C_GQ = 0, C_GK = 512, C_GV = 768, C_DQ = 1024, C_DK = 1536, C_DV = 2048, C_WQ = 2560, C_WK = 3072, C_WV = 3328, C_MQ = 3584, C_MKV = 4096, C_MKR = 4352;

constexpr size_t al256(size_t x) { return (x + 255) / 256 * 256; }
constexpr size_t SZ_WIN = (size_t)LDP * DM * 2, SZ_WUQ = (size_t)768 * 512 * 2, SZ_WUKV = (size_t)1024 * 256 * 2, SZ_WOUT = (size_t)DM * DM * 2,
                 SZ_WGU = (size_t)2 * DFF * DM * 2, SZ_WDN = (size_t)DM * DFF * 2;
constexpr size_t OFF_WIN = 0, OFF_WUQ = OFF_WIN + SZ_WIN, OFF_WUKV = OFF_WUQ + SZ_WUQ, OFF_WOUT = OFF_WUKV + SZ_WUKV, OFF_WGU = OFF_WOUT + SZ_WOUT,
                 OFF_WDN = OFF_WGU + SZ_WGU, SZ_WL = OFF_WDN + SZ_WDN;
constexpr size_t WS_W = 0;
constexpr size_t WS_MOD = al256(WS_W + 2 * SZ_WL);
constexpr size_t WS_ROPE = al256(WS_MOD + (size_t)2 * 9 * 12288 * 4);
constexpr size_t SZ_R128 = (size_t)4096 * 64 * 4, SZ_R64 = (size_t)4096 * 32 * 4;
constexpr size_t WS_MISC = al256(WS_ROPE + 2 * SZ_R128 + 2 * SZ_R64);
constexpr size_t WS_H = al256(WS_MISC + 256);
constexpr size_t WS_P = al256(WS_H + (size_t)NROWS * DM * 2);
constexpr size_t WS_QM = al256(WS_P + (size_t)NROWS * LDP * 2);
constexpr size_t WS_KVM = al256(WS_QM + (size_t)NROWS * LDQM * 2);
constexpr size_t WS_PEND = al256(WS_KVM + (size_t)NROWS * LDKVM * 2);
constexpr size_t WS_ATT = WS_PEND;
constexpr size_t WS_XC = al256(WS_ATT + (size_t)NROWS * DM * 2);
constexpr size_t WS_TMP = al256(WS_XC + (size_t)NCTX * DM * 4);
constexpr size_t WS_BAR = al256(WS_TMP + (size_t)256 * 256 * 128 * 4);
constexpr size_t WS_END = WS_BAR + 16384;
constexpr size_t WS_Y = WS_P;
constexpr size_t WS_U = WS_P;
static_assert((size_t)NROWS * DFF * 2 <= WS_PEND - WS_P, "U must fit in P region");

struct Params {
  const float* in[27];
  float* out;
  char* ws;
  float lam_init[2];
  float one_minus_lam_init[2];
};

__device__ __forceinline__ char* wsp(const Params& p);
__device__ __forceinline__ int otid() { int t = threadIdx.x; asm volatile("" : "+v"(t)); return t; }
__device__ __forceinline__ int obid() { int b = blockIdx.x; asm volatile("" : "+s"(b)); return b; }
__device__ __forceinline__ unsigned cvtpk(float lo, float hi) { unsigned r; asm volatile("v_cvt_pk_bf16_f32 %0, %1, %2" : "=v"(r) : "v"(lo), "v"(hi)); return r; }
__device__ __forceinline__ float bflo(unsigned u) { return __uint_as_float(u << 16); }
__device__ __forceinline__ float bfhi(unsigned u) { return __uint_as_float(u & 0xffff0000u); }
__device__ __forceinline__ float shflx(float v, int m, int lane) { return __int_as_float(__builtin_amdgcn_ds_bpermute((lane ^ m) << 2, __float_as_int(v))); }
__device__ __forceinline__ float wave_sum64(float v, int lane) {
  v += shflx(v, 1, lane); v += shflx(v, 2, lane); v += shflx(v, 4, lane); v += shflx(v, 8, lane); v += shflx(v, 16, lane); v += shflx(v, 32, lane); return v; }
__device__ __forceinline__ float half_sum32(float v, int lane) {
  v += shflx(v, 1, lane); v += shflx(v, 2, lane); v += shflx(v, 4, lane); v += shflx(v, 8, lane); v += shflx(v, 16, lane); return v; }


#define XB_TMO      128
#define XB_XCNT(j)  (256  + 64 * (j))
#define XB_XSUB(j)  (1280 + 64 * (j))
#define XB_XGEN(j)  (2304 + 64 * (j))
#define XB_TOP      3328
#define XB_TOPGEN   3392
#define XCD_BAR_WORDS 3456
#define XB_SPIN_CAP (1u << 18)
__device__ __forceinline__ unsigned xb_ld(unsigned* p)              { return __hip_atomic_load(p, __ATOMIC_RELAXED, __HIP_MEMORY_SCOPE_AGENT); }
__device__ __forceinline__ unsigned xb_add(unsigned* p, unsigned v) { return __hip_atomic_fetch_add(p, v, __ATOMIC_RELAXED, __HIP_MEMORY_SCOPE_AGENT); }
__device__ __forceinline__ unsigned xb_xcc_id() { return (unsigned)__builtin_amdgcn_s_getreg((3 << 11) | 20) & 0xFu; }
#define XB_SPIN(cond, bar) do { unsigned _sp = 0; while (cond) { __builtin_amdgcn_s_sleep(1); \
    if ((++_sp & 255u) == 0u) { if (xb_ld(&(bar)[XB_TMO])) break; if (_sp > XB_SPIN_CAP) { atomicAdd(&(bar)[XB_TMO], 1u); break; } } } } while (0)
struct XcdBarrier { unsigned* bar; unsigned x; volatile LAS unsigned* st; };
__device__ __forceinline__ XcdBarrier xcd_barrier_post(unsigned* bar, volatile LAS unsigned* st) {
  XcdBarrier b; b.bar = bar; b.x = (unsigned)__builtin_amdgcn_readfirstlane((int)xb_xcc_id()); b.st = st;
  if (threadIdx.x == 0) (void)xb_add(&bar[XB_XCNT(b.x)], 1u);
  return b;
}
__device__ __forceinline__ void xcd_barrier_complete(unsigned* bar, unsigned x, unsigned& nloc, unsigned& nx) {
  const unsigned G = gridDim.x * gridDim.y * gridDim.z;
  unsigned sum, cnt, mine, sp = 0u;
  for (;;) {
    sum = 0u; cnt = 0u; mine = 0u;
#pragma unroll
    for (unsigned j = 0; j < 16; ++j) { const unsigned c = xb_ld(&bar[XB_XCNT(j)]); sum += c; cnt += (c > 0u) ? 1u : 0u; mine = (j == x) ? c : mine; }
    if (sum == G) break;
    __builtin_amdgcn_s_sleep(1);
    if ((++sp & 255u) == 0u) { if (xb_ld(&bar[XB_TMO])) break; if (sp > XB_SPIN_CAP) { atomicAdd(&bar[XB_TMO], 1u); break; } }
  }
  nloc = mine > 0u ? mine : 1u; nx = cnt > 0u ? cnt : 1u;
}
__device__ __forceinline__ void xcd_barrier(const XcdBarrier& b) {
  asm volatile("s_waitcnt vmcnt(0)" ::: "memory");
  __syncthreads();
  if (threadIdx.x == 0) {
    unsigned* bar = b.bar;
    const unsigned bx = (unsigned)__builtin_amdgcn_readfirstlane((int)xb_xcc_id());
    __builtin_amdgcn_s_waitcnt(0);
    unsigned nloc = b.st[0], nx = b.st[1];
    if (nloc == 0u) { xcd_barrier_complete(bar, bx, nloc, nx); b.st[0] = nloc; b.st[1] = nx; }
    const unsigned old = xb_add(&bar[XB_XSUB(bx)], 1u);
    const unsigned gen = old / nloc;
    if (old + 1u == (gen + 1u) * nloc) {
      __builtin_amdgcn_fence(__ATOMIC_RELEASE, "agent");
      asm volatile("s_waitcnt vmcnt(0)" ::: "memory");
      const unsigned og = xb_add(&bar[XB_TOP], 1u);
      const unsigned tg = og / nx;
      if (og + 1u == (tg + 1u) * nx) xb_add(&bar[XB_TOPGEN], 1u);
      else XB_SPIN(xb_ld(&bar[XB_TOPGEN]) == tg, bar);
      __builtin_amdgcn_fence(__ATOMIC_ACQUIRE, "agent");
      xb_add(&bar[XB_XGEN(bx)], 1u);
      asm volatile("s_waitcnt vmcnt(0)" ::: "memory");
    } else {
      XB_SPIN(xb_ld(&bar[XB_XGEN(bx)]) == gen, bar);
      __builtin_amdgcn_fence(__ATOMIC_ACQUIRE, "agent");
      asm volatile("s_waitcnt vmcnt(0)" ::: "memory");
    }
  }
  __syncthreads();
}

namespace pg8 {
constexpr int BM = 256, BK = 64, HALF = 128, HTB = HALF * BK * 2, STAGE_BYTES = 8 * HTB, NXCD = 8, WGM = 8;
__device__ __forceinline__ int lds_byte(int r, int c) { const int st = (r >> 4) * 2 + (c >> 5), rr = r & 15, cc = c & 31, ob = rr * 64 + cc * 2; return st * 1024 + (ob ^ (((ob >> 9) & 1) << 5)); }
__device__ __forceinline__ void stage_rc(int b, int& R, int& C) { const int st = b / 1024, sb = b % 1024, swz = sb ^ (((sb >> 9) & 1) << 5); R = (st >> 1) * 16 + swz / 64; C = (st & 1) * 32 + (swz % 64) / 2; }
__device__ __forceinline__ int perm32(int rho) { const int n = rho >> 4, i = rho & 15; return 8 * (i >> 2) + 4 * n + (i & 3); }
struct Unit { int pm, pn; };
struct Gemm { const bf16_t* A; const bf16_t* Bt; int M, N, K, lda; };
struct StaticOrder {
  int nM, nN, nwg, G, c;
  __device__ void init(int M, int N, int G_, int c_) { nM = M / BM; nN = N / BM; nwg = nM * nN; G = G_; c = c_; }
  __device__ bool next(int i, Unit& u) const {
    const long L = (long)i * G + c; if (L >= nwg) return false;
    int wgid = (int)L; { const int q = nwg / NXCD, r = nwg % NXCD, xcd = wgid % NXCD, off = wgid / NXCD; wgid = (xcd < r ? xcd * (q + 1) : r * (q + 1) + (xcd - r) * q) + off; }
    const int nig = WGM * nN, gid = wgid / nig, fm = gid * WGM, gsz = (nM - fm) < WGM ? (nM - fm) : WGM;
    u.pm = fm + ((wgid % nig) % gsz); u.pn = (wgid % nig) / gsz; return true;
  }
};
struct EpiBf16 {
  bf16_t* O; int ldc;
  __device__ __forceinline__ void operator()(const f32x4 (&acc)[2][2][4][2], const Unit& u, int wr, int wc, int fr, int fq) const {
    const int row0 = u.pm * BM + wr * 64 + fr, col0 = u.pn * BM + wc * 32 + 8 * fq;
#pragma unroll
    for (int ai = 0; ai < 2; ++ai)
#pragma unroll
      for (int m = 0; m < 4; ++m) { bf16_t* rowp = O + (size_t)(row0 + ai * HALF + m * 16) * ldc + col0;
#pragma unroll
        for (int bj = 0; bj < 2; ++bj) { const f32x4 v0 = acc[ai][bj][m][0], v1 = acc[ai][bj][m][1];
          u32x4 w; w.x = cvtpk(v0[0], v0[1]); w.y = cvtpk(v0[2], v0[3]); w.z = cvtpk(v1[0], v1[1]); w.w = cvtpk(v1[2], v1[3]);
          *(u32x4*)(rowp + bj * HALF) = w; } }
  }
};
__device__ __forceinline__ float swiglu1(float g, float u) { return g * __builtin_amdgcn_rcpf(1.0f + __builtin_amdgcn_exp2f(-1.4426950408889634f * g)) * u; }
struct EpiSwiGLU {
  bf16_t* O; int ldc;
  __device__ __forceinline__ void operator()(const f32x4 (&acc)[2][2][4][2], const Unit& u, int wr, int wc, int fr, int fq) const {
    const int row0 = u.pm * BM + wr * 64 + fr, col0 = u.pn * HALF + wc * 32 + 8 * fq;
#pragma unroll
    for (int ai = 0; ai < 2; ++ai)
#pragma unroll
      for (int m = 0; m < 4; ++m) { bf16_t* rowp = O + (size_t)(row0 + ai * HALF + m * 16) * ldc + col0;
        const f32x4 g0 = acc[ai][0][m][0], g1 = acc[ai][0][m][1], u0 = acc[ai][1][m][0], u1 = acc[ai][1][m][1];
        u32x4 w; w.x = cvtpk(swiglu1(g0[0], u0[0]), swiglu1(g0[1], u0[1])); w.y = cvtpk(swiglu1(g0[2], u0[2]), swiglu1(g0[3], u0[3]));
        w.z = cvtpk(swiglu1(g1[0], u1[0]), swiglu1(g1[1], u1[1])); w.w = cvtpk(swiglu1(g1[2], u1[2]), swiglu1(g1[3], u1[3]));
        *(u32x4*)rowp = w; }
  }
};

template <class Epi>
__device__ __forceinline__ void gemm_phase(LAS unsigned char* lds, const Gemm g, const StaticOrder& S, const Epi& E) {
  int tid = threadIdx.x; asm volatile("" : "+v"(tid));
  const int wid = __builtin_amdgcn_readfirstlane(tid >> 6), lane = tid & 63, wr = wid >> 2, wc = wid & 3, fr = lane & 15, fq = lane >> 4;
  const int K = g.K, nt = K / BK, lda = g.lda;
  unsigned voffA[2], voffB[2];
#pragma unroll
  for (int i = 0; i < 2; ++i) { int R, C; stage_rc(tid * 16 + i * 8192, R, C); const int Rb = (R & ~31) + perm32(R & 31);
    voffA[i] = (unsigned)(R * lda + C) * 2u; voffB[i] = (unsigned)(Rb * K + C) * 2u; }
  const size_t kstep = (size_t)(BK * 2);
  const size_t hstepA = (size_t)HALF * lda * 2, tstepA = 2 * hstepA;
  const size_t hstepB = (size_t)HALF * K * 2, tstepB = 2 * hstepB;
  const unsigned ldsw = (unsigned)wid * 1024u;
  const int aoff = lds_byte(wr * 64 + fr, fq * 8), boff = lds_byte(wc * 32 + fr, fq * 8);
#define PG8_SA(b, h) (((b) * 2 + (h)) * HTB)
#define PG8_SB(b, h) ((4 + (b) * 2 + (h)) * HTB)
#define PG8_STAGE(bufoff, gbase, voff) do { _Pragma("unroll") for (int _i = 0; _i < 2; ++_i) \
    __builtin_amdgcn_global_load_lds((const unsigned*)((const char*)(gbase) + (voff)[_i]), (LAS unsigned*)(lds + (bufoff) + ldsw + _i * 8192), 16, 0, 0); } while (0)
#define PG8_LDA(dst, b, h) do { _Pragma("unroll") for (int m = 0; m < 4; ++m) _Pragma("unroll") for (int k = 0; k < 2; ++k) dst[m][k] = *(const LAS bf16x8*)(lds + PG8_SA(b, h) + aoff + m * 2048 + k * 1024); } while (0)
#define PG8_LDB(dst, b, h) do { _Pragma("unroll") for (int n = 0; n < 2; ++n) _Pragma("unroll") for (int k = 0; k < 2; ++k) dst[n][k] = *(const LAS bf16x8*)(lds + PG8_SB(b, h) + boff + n * 2048 + k * 1024); } while (0)
#define PG8_MMA(ai, bj, At, Bt) do { __builtin_amdgcn_s_setprio(1); _Pragma("unroll") for (int m = 0; m < 4; ++m) _Pragma("unroll") for (int n = 0; n < 2; ++n) _Pragma("unroll") for (int k = 0; k < 2; ++k) \
    acc[ai][bj][m][n] = __builtin_amdgcn_mfma_f32_16x16x32_bf16(Bt[n][k], At[m][k], acc[ai][bj][m][n], 0, 0, 0); __builtin_amdgcn_s_setprio(0); } while (0)
#define PG8_WAIT_V(n) asm volatile("s_waitcnt vmcnt(" #n ")" ::: "memory")
#define PG8_WAIT_L(n) asm volatile("s_waitcnt lgkmcnt(" #n ")" ::: "memory")
#define PG8_BAR __builtin_amdgcn_s_barrier()
#define PG8_SCHED __builtin_amdgcn_sched_barrier(0)
  Unit cur, nxt; int ui = 0;
  if (!S.next(0, cur)) return;
  f32x4 acc[2][2][4][2];
#pragma unroll
  for (int a = 0; a < 2; ++a)
#pragma unroll
    for (int b = 0; b < 2; ++b)
#pragma unroll
      for (int m = 0; m < 4; ++m)
#pragma unroll
        for (int n = 0; n < 2; ++n) acc[a][b][m][n] = (f32x4){0.f, 0.f, 0.f, 0.f};
  bf16x8 At[4][2], B0[2][2], B1[2][2];
  const char* cA = (const char*)g.A + (size_t)cur.pm * tstepA; const char* cB = (const char*)g.Bt + (size_t)cur.pn * tstepB;
  PG8_STAGE(PG8_SB(0, 0), cB, voffB); PG8_STAGE(PG8_SA(0, 0), cA, voffA); PG8_STAGE(PG8_SB(0, 1), cB + hstepB, voffB); PG8_STAGE(PG8_SA(0, 1), cA + hstepA, voffA);
  if (wr == 1) PG8_BAR;
  PG8_WAIT_V(4); PG8_BAR;
  PG8_STAGE(PG8_SB(1, 0), cB + kstep, voffB); PG8_STAGE(PG8_SA(1, 0), cA + kstep, voffA); PG8_STAGE(PG8_SB(1, 1), cB + hstepB + kstep, voffB);
  PG8_WAIT_V(6); PG8_BAR;
  for (;;) {
    const bool has_next = S.next(ui + 1, nxt);
    const char* nA = has_next ? (const char*)g.A + (size_t)nxt.pm * tstepA : cA; const char* nB = has_next ? (const char*)g.Bt + (size_t)nxt.pn * tstepB : cB;
    for (int t = 0; t < nt; t += 2) {
      const bool last = (t == nt - 2);
      const char* a1 = cA + (size_t)(t + 1) * kstep;
      const char* a2 = last ? nA : cA + (size_t)(t + 2) * kstep; const char* b2 = last ? nB : cB + (size_t)(t + 2) * kstep;
      const char* a3 = a2 + kstep; const char* b3 = b2 + kstep;
      PG8_LDB(B0, 0, 0); PG8_SCHED; PG8_LDA(At, 0, 0); PG8_STAGE(PG8_SA(1, 1), a1 + hstepA, voffA);
      PG8_WAIT_L(8); PG8_BAR; PG8_WAIT_L(0); PG8_MMA(0, 0, At, B0); PG8_BAR; PG8_SCHED;
      PG8_LDB(B1, 0, 1); PG8_STAGE(PG8_SB(0, 0), b2, voffB);
      PG8_BAR; PG8_WAIT_L(0); PG8_MMA(0, 1, At, B1); PG8_BAR;
      PG8_LDA(At, 0, 1); PG8_STAGE(PG8_SA(0, 0), a2, voffA);
      PG8_BAR; PG8_WAIT_L(0); PG8_MMA(1, 0, At, B0); PG8_BAR; PG8_SCHED;
      PG8_STAGE(PG8_SB(0, 1), b2 + hstepB, voffB);
      PG8_WAIT_V(6); PG8_BAR; PG8_MMA(1, 1, At, B1); PG8_BAR;
      PG8_LDB(B0, 1, 0); PG8_SCHED; PG8_LDA(At, 1, 0); PG8_STAGE(PG8_SA(0, 1), a2 + hstepA, voffA);
      PG8_WAIT_L(8); PG8_BAR; PG8_WAIT_L(0); PG8_MMA(0, 0, At, B0); PG8_BAR; PG8_SCHED;
      PG8_LDB(B1, 1, 1); PG8_STAGE(PG8_SB(1, 0), b3, voffB);
      PG8_BAR; PG8_WAIT_L(0); PG8_MMA(0, 1, At, B1); PG8_BAR;
      PG8_LDA(At, 1, 1); PG8_STAGE(PG8_SA(1, 0), a3, voffA);
      PG8_BAR; PG8_WAIT_L(0); PG8_MMA(1, 0, At, B0); PG8_BAR; PG8_SCHED;
      PG8_STAGE(PG8_SB(1, 1), b3 + hstepB, voffB);
      PG8_WAIT_V(6); PG8_BAR; PG8_MMA(1, 1, At, B1); PG8_BAR;
    }
    E(acc, cur, wr, wc, fr, fq);
    if (!has_next) break;
#pragma unroll
    for (int a = 0; a < 2; ++a)
#pragma unroll
      for (int b = 0; b < 2; ++b)
#pragma unroll
        for (int m = 0; m < 4; ++m)
#pragma unroll
          for (int n = 0; n < 2; ++n) acc[a][b][m][n] = (f32x4){0.f, 0.f, 0.f, 0.f};
    cur = nxt; cA = nA; cB = nB; ++ui;
  }
  PG8_WAIT_V(0);
  if (wr == 0) PG8_BAR;
  PG8_BAR;
#undef PG8_SA
#undef PG8_SB
#undef PG8_STAGE
#undef PG8_LDA
#undef PG8_LDB
#undef PG8_MMA
#undef PG8_WAIT_V
#undef PG8_WAIT_L
#undef PG8_BAR
#undef PG8_SCHED
}
}

constexpr size_t SHM_V = 64 * 128 * 2;
#define SBAR() __builtin_amdgcn_sched_barrier(0)
__device__ __forceinline__ int crow(int r, int hi) { return (r & 3) + 8 * (r >> 2) + 4 * hi; }
__device__ __forceinline__ void partialSM(f32x16& p0, f32x16& p1, float& m_reg, float& mn, float& alpha, float C, float thrs) {
  float pmax = p0[0];
#pragma unroll
  for (int r = 1; r < 16; ++r) pmax = fmaxf(pmax, p0[r]);
#pragma unroll
  for (int r = 0; r < 16; ++r) pmax = fmaxf(pmax, p1[r]);
  { auto rr = __builtin_amdgcn_permlane32_swap(__float_as_uint(pmax), __float_as_uint(pmax), false, false);
    pmax = fmaxf(__uint_as_float(rr[0]), __uint_as_float(rr[1])); }
  if (__builtin_expect(__all(pmax - m_reg <= thrs), 1)) { mn = m_reg; alpha = 1.f; }
  else { mn = fmaxf(m_reg, pmax); alpha = __builtin_amdgcn_exp2f((m_reg - mn) * C); m_reg = mn; }
  float mnC = -mn * C;
#pragma unroll
  for (int r = 0; r < 16; ++r) p0[r] = fmaf(p0[r], C, mnC);
#pragma unroll
  for (int r = 0; r < 16; ++r) p1[r] = fmaf(p1[r], C, mnC);
#pragma unroll
  for (int r = 0; r < 16; ++r) p0[r] = __builtin_amdgcn_exp2f(p0[r]);
}
__device__ __forceinline__ void finishSM(f32x16& p0, f32x16& p1, float alpha, float& l_reg, bf16x8& pa0, bf16x8& pa1, bf16x8& pa2, bf16x8& pa3) {
#pragma unroll
  for (int r = 0; r < 16; ++r) p1[r] = __builtin_amdgcn_exp2f(p1[r]);
  float ps = 0;
#pragma unroll
  for (int r = 0; r < 16; ++r) ps += p0[r];
#pragma unroll
  for (int r = 0; r < 16; ++r) ps += p1[r];
  { auto rr = __builtin_amdgcn_permlane32_swap(__float_as_uint(ps), __float_as_uint(ps), false, false);
    ps = __uint_as_float(rr[0]) + __uint_as_float(rr[1]); }
  l_reg = l_reg * alpha + ps;
#define PK4(P, BASE, OUT) do { unsigned a0 = cvtpk(P[BASE + 0], P[BASE + 1]), a1 = cvtpk(P[BASE + 2], P[BASE + 3]);   \
    unsigned b0 = cvtpk(P[BASE + 4], P[BASE + 5]), b1 = cvtpk(P[BASE + 6], P[BASE + 7]);                              \
    auto r0 = __builtin_amdgcn_permlane32_swap(a0, b0, false, false); auto r1 = __builtin_amdgcn_permlane32_swap(a1, b1, false, false); \
    u32x4 w = {r0[0], r1[0], r0[1], r1[1]}; OUT = *reinterpret_cast<bf16x8*>(&w); } while (0)
  PK4(p0, 0, pa0); PK4(p0, 8, pa1); PK4(p1, 0, pa2); PK4(p1, 8, pa3);
#undef PK4
}
template <int DQK> __device__ __forceinline__ int kswz(int row, int colB) { return row * (DQK * 2) + (colB ^ ((row & 7) << 4)); }
template <int DQK>
__device__ __forceinline__ void qkt(f32x16& p0, f32x16& p1, const char* Ks, const bf16x8* qr, int r32, int hi) {
  p0 = f32x16{}; p1 = f32x16{};
#pragma unroll
  for (int d0 = 0; d0 < DQK / 16; ++d0) { int cb = (d0 * 16 + hi * 8) * 2;
    bf16x8 b0 = *reinterpret_cast<const bf16x8*>(Ks + kswz<DQK>(r32, cb));
    bf16x8 b1 = *reinterpret_cast<const bf16x8*>(Ks + kswz<DQK>(32 + r32, cb));
    p0 = __builtin_amdgcn_mfma_f32_32x32x16_bf16(b0, qr[d0], p0, 0, 0, 0);
    p1 = __builtin_amdgcn_mfma_f32_32x32x16_bf16(b1, qr[d0], p1, 0, 0, 0); }
}
__device__ __forceinline__ int v_st(int k, int c) { const int kk = (k & ~0xC) | ((k & 4) << 1) | ((k & 8) >> 1); return ((kk >> 3) * 4 + (c >> 5)) * 512 + ((kk & 7) * 32 + (c & 31)) * 2; }
__device__ __forceinline__ int v_rd_base(int lane) { return ((lane & 3) << 3) | (((lane >> 2) & 3) << 6) | (((lane >> 4) & 1) << 5) | (((lane >> 5) & 1) << 8); }
constexpr int v_rd_off(int d0, int ks, int half) { return d0 * 512 + ks * 4096 + half * 2048; }
template <int OFF> __device__ __forceinline__ s16x4 tr_read(int vb) {
  s16x4 r; asm volatile("ds_read_b64_tr_b16 %0, %1 offset:%2" : "=&v"(r) : "v"(vb), "i"(OFF) : "memory"); return r;
}
template <int D0> __device__ __forceinline__ void pv_one(f32x16& od, int vb, bf16x8 pa0, bf16x8 pa1, bf16x8 pa2, bf16x8 pa3) {
  const s16x4 l0 = tr_read<v_rd_off(D0, 0, 0)>(vb), h0 = tr_read<v_rd_off(D0, 0, 1)>(vb), l1 = tr_read<v_rd_off(D0, 1, 0)>(vb), h1 = tr_read<v_rd_off(D0, 1, 1)>(vb);
  const s16x4 l2 = tr_read<v_rd_off(D0, 2, 0)>(vb), h2 = tr_read<v_rd_off(D0, 2, 1)>(vb), l3 = tr_read<v_rd_off(D0, 3, 0)>(vb), h3 = tr_read<v_rd_off(D0, 3, 1)>(vb);
  asm volatile("s_waitcnt lgkmcnt(0)" ::: "memory"); SBAR();
#define PK(L, H) (bf16x8){L[0], L[1], L[2], L[3], H[0], H[1], H[2], H[3]}
  od = __builtin_amdgcn_mfma_f32_32x32x16_bf16(pa0, PK(l0, h0), od, 0, 0, 0);
  od = __builtin_amdgcn_mfma_f32_32x32x16_bf16(pa1, PK(l1, h1), od, 0, 0, 0);
  od = __builtin_amdgcn_mfma_f32_32x32x16_bf16(pa2, PK(l2, h2), od, 0, 0, 0);
  od = __builtin_amdgcn_mfma_f32_32x32x16_bf16(pa3, PK(l3, h3), od, 0, 0, 0);
#undef PK
}
__device__ __forceinline__ void pv_d0(f32x16* o, int vb, bf16x8 pa0, bf16x8 pa1, bf16x8 pa2, bf16x8 pa3) {
  pv_one<0>(o[0], vb, pa0, pa1, pa2, pa3); pv_one<1>(o[1], vb, pa0, pa1, pa2, pa3); pv_one<2>(o[2], vb, pa0, pa1, pa2, pa3); pv_one<3>(o[3], vb, pa0, pa1, pa2, pa3);
}

struct AttnArgs {
  const bf16_t* Q; int ldq;
  const bf16_t* K; int ldk;
  const bf16_t* K2; int ldk2;
  const bf16_t* V; int ldv;
  int crow0, lrow0, NT;
  float C, thrs;
  bf16_t* O; int ldo;
  float* tmp;
  float lam, postmul; const float* subln;
  float sinkl2;
  int q0, kstart;
  const float* rc; const float* rs; int tq0;
  const float* qgain;
};
template <int DQK, int MODE, int SDEPTH, int QT>
__device__ __forceinline__ void attn_unit(const AttnArgs& a, char* lds) {
  constexpr int SHM_K = 64 * DQK * 2;
  constexpr int NLD = (DQK == 64 ? 3 : (DQK == 128 ? 4 : 5));
  int tid = threadIdx.x; asm volatile("" : "+v"(tid));
  const int wid = tid >> 6, lane = tid & 63, r32 = lane & 31, hi = lane >> 5;
  char* V_lds = lds; char* K_lds = lds + 2 * SHM_V;
  float* wsl = (float*)(lds + 2 * SHM_V + 2 * SHM_K) + wid * 64; float* li_l = wsl; float* al_l = wsl + 32;
  float m_reg = -1e30f, l_reg = 0; f32x16 o[4] = {}; bf16x8 qr[DQK / 16];
  const float C = a.C, thrs = a.thrs;
  const bf16_t* Qw = a.Q + (size_t)(wid * 32 + r32) * a.ldq + hi * 8;
#pragma unroll
  for (int d0 = 0; d0 < DQK / 16; ++d0) qr[d0] = *reinterpret_cast<const bf16x8*>(Qw + d0 * 16);
  if constexpr (QT == 1) {
    float ss = 0.f;
#pragma unroll
    for (int d0 = 0; d0 < 8; ++d0) { const u32x4 w = *reinterpret_cast<u32x4*>(&qr[d0]);
#pragma unroll
      for (int e = 0; e < 4; ++e) { const float lo = bflo(w[e]), hh = bfhi(w[e]); ss += lo * lo + hh * hh; } }
    ss += shflx(ss, 32, lane);
    const float rstd = rsqrtf(ss * (1.0f / 128.0f) + EPS);
#pragma unroll
    for (int d0 = 0; d0 < 8; ++d0) { const float* gp = a.qgain + d0 * 16 + hi * 8; const f32x4 g0 = *(const f32x4*)gp, g1 = *(const f32x4*)(gp + 4);
      const u32x4 w = *reinterpret_cast<u32x4*>(&qr[d0]); u32x4 y;
      y.x = cvtpk(bflo(w.x) * rstd * g0[0], bfhi(w.x) * rstd * g0[1]); y.y = cvtpk(bflo(w.y) * rstd * g0[2], bfhi(w.y) * rstd * g0[3]);
      y.z = cvtpk(bflo(w.z) * rstd * g1[0], bfhi(w.z) * rstd * g1[1]); y.w = cvtpk(bflo(w.w) * rstd * g1[2], bfhi(w.w) * rstd * g1[3]);
      qr[d0] = *reinterpret_cast<bf16x8*>(&y); }
  }
  if constexpr (QT != 0) {
    if (a.tq0 >= 0) {
      constexpr int RB = (DQK == 192) ? 8 : 0, RH = (DQK == 128) ? 64 : 32;
      const int t = a.tq0 + wid * 32 + r32;
#pragma unroll
      for (int g = 0; g < RH / 16; ++g) {
        const float* cp = a.rc + (size_t)t * RH + g * 16 + hi * 8; const float* sp = a.rs + (size_t)t * RH + g * 16 + hi * 8;
        const f32x4 c0 = *(const f32x4*)cp, c1 = *(const f32x4*)(cp + 4), s0 = *(const f32x4*)sp, s1 = *(const f32x4*)(sp + 4);
        const u32x4 xa = *reinterpret_cast<u32x4*>(&qr[RB + g]), xb = *reinterpret_cast<u32x4*>(&qr[RB + g + RH / 16]);
        u32x4 ya, yb;
#pragma unroll
        for (int w = 0; w < 4; ++w) {
          const float cl = w < 2 ? c0[2 * w] : c1[2 * w - 4], ch = w < 2 ? c0[2 * w + 1] : c1[2 * w - 3];
          const float sl = w < 2 ? s0[2 * w] : s1[2 * w - 4], sh = w < 2 ? s0[2 * w + 1] : s1[2 * w - 3];
          const float x1l = bflo(xa[w]), x1h = bfhi(xa[w]), x2l = bflo(xb[w]), x2h = bfhi(xb[w]);
          ya[w] = cvtpk(x1l * cl - x2l * sl, x1h * ch - x2h * sh);
          yb[w] = cvtpk(x2l * cl + x1l * sl, x2h * ch + x1h * sh);
        }
        qr[RB + g] = *reinterpret_cast<bf16x8*>(&ya); qr[RB + g + RH / 16] = *reinterpret_cast<bf16x8*>(&yb);
      }
    }
  }
  const int sr = tid >> 4, sc = (tid & 15) * 8, vst0 = v_st(sr, sc), vst1 = v_st(32 + sr, sc);
  const int kr = tid >> 3, kc = (tid & 7) * 8;
  const int vb0 = (int)(uintptr_t)V_lds + v_rd_base(lane);
  struct { bf16x8 vs0, vs1, ks0, ks1, ks2; } sr_[SDEPTH];
#define KROW(j) ((j) < 4 ? a.crow0 + (j) * 64 : a.lrow0 + ((j) - 4) * 64)
  const unsigned voV = (unsigned)(sr * a.ldv + sc) * 2u, voK = (DQK == 64) ? (unsigned)(kr * a.ldk + kc) * 2u : (unsigned)(sr * a.ldk + sc) * 2u, voK2 = (DQK == 192) ? (unsigned)(kr * a.ldk2 + kc) * 2u : 0u;
#define SLOAD(i, j) do { const int rb_ = __builtin_amdgcn_readfirstlane(KROW(j)); \
    const char* vb_ = (const char*)a.V + (size_t)rb_ * a.ldv * 2; const char* kb_ = (const char*)a.K + (size_t)rb_ * a.ldk * 2; \
    sr_[i].vs0 = *(const bf16x8*)(vb_ + voV); sr_[i].vs1 = *(const bf16x8*)(vb_ + (size_t)a.ldv * 64 + voV); \
    if constexpr (DQK == 64) { sr_[i].ks0 = *(const bf16x8*)(kb_ + voK); } \
    else { sr_[i].ks0 = *(const bf16x8*)(kb_ + voK); sr_[i].ks1 = *(const bf16x8*)(kb_ + (size_t)a.ldk * 64 + voK); } \
    if constexpr (DQK == 192) { sr_[i].ks2 = *(const bf16x8*)((const char*)a.K2 + (size_t)rb_ * a.ldk2 * 2 + voK2); } } while (0)
#define SWRITE(b, i) do { *(bf16x8*)(V_lds + (b) * SHM_V + vst0) = sr_[i].vs0; *(bf16x8*)(V_lds + (b) * SHM_V + vst1) = sr_[i].vs1; \
    if constexpr (DQK == 64) { *(bf16x8*)(K_lds + (b) * SHM_K + kswz<DQK>(kr, kc * 2)) = sr_[i].ks0; } \
    else { *(bf16x8*)(K_lds + (b) * SHM_K + kswz<DQK>(sr, sc * 2)) = sr_[i].ks0; *(bf16x8*)(K_lds + (b) * SHM_K + kswz<DQK>(32 + sr, sc * 2)) = sr_[i].ks1; } \
    if constexpr (DQK == 192) { *(bf16x8*)(K_lds + (b) * SHM_K + kswz<DQK>(kr, (128 + kc) * 2)) = sr_[i].ks2; } } while (0)
#define SWAIT() do { if constexpr (SDEPTH == 2) asm volatile("s_waitcnt vmcnt(%0)" :: "n"(NLD) : "memory"); else asm volatile("s_waitcnt vmcnt(0)" ::: "memory"); } while (0)
#define RESC(al) do { if (__any((al) < 1.f)) { if (hi == 0) al_l[r32] = (al); asm volatile("s_waitcnt lgkmcnt(0)" ::: "memory"); \
    _Pragma("unroll") for (int d = 0; d < 4; ++d) _Pragma("unroll") for (int r = 0; r < 16; ++r) o[d][r] *= al_l[crow(r, hi)]; } } while (0)
#define MASK(P0, P1, j) do { if constexpr (MODE == 3) { if ((j) >= 4) { const int dq_ = a.kstart + ((j) - 4) * 64 - (a.q0 + wid * 32 + r32); \
    _Pragma("unroll") for (int r = 0; r < 16; ++r) { const int d0_ = dq_ + crow(r, hi), d1_ = d0_ + 32; \
      if (d0_ > 128 || d0_ < -128) P0[r] = -1e30f; if (d1_ > 128 || d1_ < -128) P1[r] = -1e30f; } } } } while (0)
  f32x16 pA0, pA1, pB0, pB1; float mnA, mnB, alA, alB; bf16x8 pa0, pa1, pa2, pa3; const int NT = a.NT;
  constexpr int SE = 0, SO = SDEPTH - 1;
  if constexpr (SDEPTH == 2) {
    SLOAD(SE, 0); SLOAD(SO, 1); SWAIT(); SWRITE(0, SE); if (2 < NT) SLOAD(SE, 2); __syncthreads();
    qkt<DQK>(pA0, pA1, K_lds, qr, r32, hi); MASK(pA0, pA1, 0); partialSM(pA0, pA1, m_reg, mnA, alA, C, thrs);
    SWAIT(); SWRITE(1, SO); __syncthreads();
  } else {
    SLOAD(SE, 0); asm volatile("s_waitcnt vmcnt(0)" ::: "memory"); SWRITE(0, SE); SLOAD(SO, 1); __syncthreads();
    qkt<DQK>(pA0, pA1, K_lds, qr, r32, hi); MASK(pA0, pA1, 0); partialSM(pA0, pA1, m_reg, mnA, alA, C, thrs);
    SWAIT(); SWRITE(1, SO); __syncthreads();
  }
  for (int j = 1; j + 1 < NT; j += 2) {
    SBAR(); qkt<DQK>(pB0, pB1, K_lds + SHM_K, qr, r32, hi); MASK(pB0, pB1, j);
    finishSM(pA0, pA1, alA, l_reg, pa0, pa1, pa2, pa3); SBAR();
    if constexpr (SDEPTH == 2) { SLOAD(SO, j + 2); } else { SLOAD(SE, j + 1); } SBAR();
    pv_d0(o, vb0, pa0, pa1, pa2, pa3); partialSM(pB0, pB1, m_reg, mnB, alB, C, thrs);
    __syncthreads(); SWAIT(); SWRITE(0, SE);
    RESC(alB); __syncthreads();
    SBAR(); qkt<DQK>(pA0, pA1, K_lds, qr, r32, hi); MASK(pA0, pA1, j + 1);
    finishSM(pB0, pB1, alB, l_reg, pa0, pa1, pa2, pa3); SBAR();
    if constexpr (SDEPTH == 2) { if (j + 3 < NT) SLOAD(SE, j + 3); } else { SLOAD(SO, j + 2); } SBAR();
    pv_d0(o, vb0 + (int)SHM_V, pa0, pa1, pa2, pa3); partialSM(pA0, pA1, m_reg, mnA, alA, C, thrs);
    __syncthreads(); SWAIT(); SWRITE(1, SO);
    RESC(alA); __syncthreads();
  }
  SBAR(); qkt<DQK>(pB0, pB1, K_lds + SHM_K, qr, r32, hi); MASK(pB0, pB1, NT - 1);
  finishSM(pA0, pA1, alA, l_reg, pa0, pa1, pa2, pa3); SBAR();
  pv_d0(o, vb0, pa0, pa1, pa2, pa3); partialSM(pB0, pB1, m_reg, mnB, alB, C, thrs);
  __syncthreads(); RESC(alB);
  finishSM(pB0, pB1, alB, l_reg, pa0, pa1, pa2, pa3); SBAR();
  pv_d0(o, vb0 + (int)SHM_V, pa0, pa1, pa2, pa3);
  if constexpr (MODE == 3) l_reg += __builtin_amdgcn_exp2f(a.sinkl2 - m_reg * C);
  if (hi == 0) li_l[r32] = l_reg; asm volatile("s_waitcnt lgkmcnt(0)" ::: "memory");
  float rli[16];
#pragma unroll
  for (int r = 0; r < 16; ++r) rli[r] = __builtin_amdgcn_rcpf(li_l[crow(r, hi)]);
  char* R = lds + 61440 + wid * 8704;
  if constexpr (MODE == 0 || MODE == 3) __syncthreads();
  if constexpr (MODE == 2) {
    float g[4];
#pragma unroll
    for (int d0 = 0; d0 < 4; ++d0) g[d0] = a.subln[d0 * 32 + r32] * a.postmul;
#pragma unroll
    for (int r = 0; r < 16; ++r) { char* Rr = R + crow(r, hi) * 272 + r32 * 2;
      float v[4], ss = 0.f;
#pragma unroll
      for (int d0 = 0; d0 < 4; ++d0) { const float o1 = __uint_as_float((unsigned)(*(const unsigned short*)(Rr + d0 * 64)) << 16); v[d0] = o1 - a.lam * (o[d0][r] * rli[r]); ss += v[d0] * v[d0]; }
      ss = half_sum32(ss, lane);
      const float rstd = rsqrtf(ss * (1.0f / 128.0f) + EPS);
#pragma unroll
      for (int d0 = 0; d0 < 4; ++d0) *(unsigned short*)(Rr + d0 * 64) = (unsigned short)(cvtpk(v[d0] * rstd * g[d0], 0.f) & 0xffffu); }
  } else {
#pragma unroll
    for (int r = 0; r < 16; ++r) { char* Rr = R + crow(r, hi) * 272 + r32 * 2;
#pragma unroll
      for (int d0 = 0; d0 < 4; ++d0) *(unsigned short*)(Rr + d0 * 64) = (unsigned short)(cvtpk(o[d0][r] * rli[r], 0.f) & 0xffffu); }
  }
  if constexpr (MODE != 1) {
    asm volatile("s_waitcnt lgkmcnt(0)" ::: "memory");
    bf16_t* Ow = a.O + (size_t)(wid * 32) * a.ldo;
#pragma unroll
    for (int i = 0; i < 8; ++i) { const int c = i * 64 + lane, row = c >> 4, cc = c & 15;
      const u32x4 w = *(const u32x4*)(R + row * 272 + cc * 16);
      *(u32x4*)(Ow + (size_t)row * a.ldo + cc * 8) = w; }
  }
  __syncthreads();
#undef KROW
#undef SLOAD
#undef SWRITE
#undef SWAIT
#undef RESC
#undef MASK
}

struct TJob { const float* src; const float* src2; bf16_t* dst; int K, Nsrc, Nd, mode; };
__device__ __forceinline__ TJob tjob(const Params& p, int l, int m) {
  char* W = p.ws + WS_W + (size_t)l * SZ_WL; TJob j; j.src2 = nullptr; j.mode = 0;
  switch (m) {
    case 0: j.src = p.in[10] + (size_t)l * DM * INC; j.dst = (bf16_t*)(W + OFF_WIN); j.K = DM; j.Nsrc = INC; j.Nd = LDP; break;
    case 1: j.src = p.in[20] + (size_t)l * 512 * 768; j.dst = (bf16_t*)(W + OFF_WUQ); j.K = 512; j.Nsrc = 768; j.Nd = 768; break;
    case 2: j.src = p.in[22] + (size_t)l * 256 * 1024; j.dst = (bf16_t*)(W + OFF_WUKV); j.K = 256; j.Nsrc = 1024; j.Nd = 1024; break;
    case 3: j.src = p.in[23] + (size_t)l * DM * DM; j.dst = (bf16_t*)(W + OFF_WOUT); j.K = DM; j.Nsrc = DM; j.Nd = DM; break;
    case 4: j.src = p.in[24] + (size_t)l * DM * DFF; j.src2 = p.in[25] + (size_t)l * DM * DFF; j.dst = (bf16_t*)(W + OFF_WGU); j.K = DM; j.Nsrc = DFF; j.Nd = 2 * DFF; j.mode = 1; break;
    default: j.src = p.in[26] + (size_t)l * DFF * DM; j.dst = (bf16_t*)(W + OFF_WDN); j.K = DFF; j.Nsrc = DM; j.Nd = DM; break;
  }
  return j;
}
__device__ __forceinline__ void ttile(const TJob& j, int tn, int tk, float* tl) {
  const int tid = otid(), k = tid >> 3, n8 = (tid & 7) * 8, n0 = tn * 64, k0 = tk * 256;
  const float* s = j.src; int scol = n0;
  if (j.mode == 1) { const int pn = n0 >> 8, r = n0 & 255; s = (r < 128) ? j.src : j.src2; scol = pn * 128 + (r & 127); }
  f32x4 va[4], vb[4];
  const bool nz = (j.mode == 1 || n0 < j.Nsrc);
#pragma unroll
  for (int kk = 0; kk < 4; ++kk) { va[kk] = (f32x4){0.f, 0.f, 0.f, 0.f}; vb[kk] = va[kk];
    if (nz) { const float* q = s + (size_t)(k0 + kk * 64 + k) * j.Nsrc + scol + n8; va[kk] = *(const f32x4*)q; vb[kk] = *(const f32x4*)(q + 4); } }
  __syncthreads();
#pragma unroll
  for (int kk = 0; kk < 4; ++kk)
#pragma unroll
    for (int i = 0; i < 4; ++i) { tl[(kk * 64 + k) * 65 + n8 + i] = va[kk][i]; tl[(kk * 64 + k) * 65 + n8 + 4 + i] = vb[kk][i]; }
  __syncthreads();
  const int n = tid >> 3, k8 = (tid & 7) * 8;
#pragma unroll
  for (int kk = 0; kk < 4; ++kk) {
    float v[8];
#pragma unroll
    for (int i = 0; i < 8; ++i) v[i] = tl[(kk * 64 + k8 + i) * 65 + n];
    u32x4 w = {cvtpk(v[0], v[1]), cvtpk(v[2], v[3]), cvtpk(v[4], v[5]), cvtpk(v[6], v[7])};
    *(u32x4*)(j.dst + (size_t)(n0 + n) * j.K + k0 + kk * 64 + k8) = w;
  }
}
__device__ __forceinline__ void phase0(const Params& p, char* lds) {
  const int tid = otid(), G = gridDim.x, bid = obid();
  float* tl = (float*)lds;
  int base = 0;
  for (int l = 0; l < 2; ++l)
    for (int m = 0; m < 6; ++m) {
      const TJob j = tjob(p, l, m); const int ntn = j.Nd / 64, ntk = j.K / 256, total = ntn * ntk;
      int first = (bid - (base % G) + G) % G;
      for (int t = first; t < total; t += G) ttile(j, t / ntk, t % ntk, tl);
      base += total;
    }
  __syncthreads();
  float* sv = (float*)lds;
  float* red = sv + 9 * DM;
  for (int i = tid; i < 9 * DM; i += 512) { const int r = i / DM, k = i % DM; const float c = (r < 8) ? p.in[1][r * DM + k] : p.in[3][k]; sv[i] = c / (1.0f + expf(-c)); }
  __syncthreads();
  float* mod = (float*)(p.ws + WS_MOD);
  for (int u = bid; u < 2 * 384; u += G) {
    const int l = u / 384, n0 = (u % 384) * 32, cl = tid & 7, sl = tid >> 3;
    const float* w = p.in[4] + (size_t)l * DM * 12288 + n0 + 4 * cl;
    f32x4 acc[9];
#pragma unroll
    for (int r = 0; r < 9; ++r) acc[r] = (f32x4){0.f, 0.f, 0.f, 0.f};
#pragma unroll 8
    for (int k = sl * 32; k < sl * 32 + 32; ++k) { const f32x4 wv = *(const f32x4*)(w + (size_t)k * 12288);
#pragma unroll
      for (int r = 0; r < 9; ++r) acc[r] += wv * sv[r * DM + k]; }
    const int lane = tid & 63;
#pragma unroll
    for (int r = 0; r < 9; ++r)
#pragma unroll
      for (int e = 0; e < 4; ++e) { float v = acc[r][e]; v += shflx(v, 8, lane); v += shflx(v, 16, lane); v += shflx(v, 32, lane); acc[r][e] = v; }
    if (lane < 8) {
#pragma unroll
      for (int r = 0; r < 9; ++r) *(f32x4*)(red + ((tid >> 6) * 9 + r) * 32 + 4 * lane) = acc[r];
    }
    __syncthreads();
    if (tid < 288) { const int r = tid >> 5, c2 = tid & 31; float t = 0.f;
#pragma unroll
      for (int s2 = 0; s2 < 8; ++s2) t += red[(s2 * 9 + r) * 32 + c2];
      mod[((size_t)l * 9 + r) * 12288 + n0 + c2] = t + p.in[5][(size_t)l * 12288 + n0 + c2]; }
    __syncthreads();
  }
  float* c128 = (float*)(p.ws + WS_ROPE); float* s128 = c128 + 4096 * 64; float* c64 = s128 + 4096 * 64; float* s64 = c64 + 4096 * 32;
  for (int i = bid * 512 + tid; i < 4096 * 64; i += G * 512) { const int t = i >> 6, a = i & 63; const float pos = (a < 32) ? (float)(t >> 6) : (float)(t & 63);
    const float inv = exp2f(-(float)(a & 31) * (13.287712379549449f / 32.0f)); const float ang = pos * inv; c128[i] = cosf(ang); s128[i] = sinf(ang); }
  for (int i = bid * 512 + tid; i < 4096 * 32; i += G * 512) { const int t = i >> 5, a = i & 31; const float pos = (a < 16) ? (float)(t >> 6) : (float)(t & 63);
    const float inv = exp2f(-(float)(a & 15) * (13.287712379549449f / 16.0f)); const float ang = pos * inv; c64[i] = cosf(ang); s64[i] = sinf(ang); }
  if (bid == 0 && tid < 128) {
    const int l = tid >> 6, i = tid & 63;
    float a1 = p.in[13][l * 64 + i] * p.in[14][l * 64 + i], a2 = p.in[15][l * 64 + i] * p.in[16][l * 64 + i];
    a1 = wave_sum64(a1, tid & 63); a2 = wave_sum64(a2, tid & 63);
    if (i == 0) ((float*)(p.ws + WS_MISC))[l] = expf(a1) - expf(a2) + p.lam_init[l];
  }
}

struct RowArgs {
  const float* xlat_in; const float* xctx_in; float* xlat_out; float* xctx_out;
  const bf16_t* xlat_in16; bf16_t* xlat_out16;
  const bf16_t* Y; const float* gpost; const float* gate;
  bf16_t* H; const float* gnext; const float* shift; const float* scale;
  int M;
  int r0, vb, vG;
};
__device__ __forceinline__ void row_phase(const RowArgs& a) {
  const int tid_ = otid(), lane = tid_ & 63, gw = a.r0 + a.vb * 8 + (tid_ >> 6), nw = a.vG * 8;
  f32x4 x[8], xn[8]; u32x2 yw[8], ywn[8], xw[8], xwn[8];
#define ROW_LOAD(X, XW, YW, r_) do { const bool lat_ = (r_) < NLAT; const float* xin_ = lat_ ? a.xlat_in + (size_t)(r_) * DM : a.xctx_in + (size_t)((r_) - NLAT) * DM; \
    if (lat_ && a.xlat_in16) { _Pragma("unroll") for (int i = 0; i < 8; ++i) XW[i] = *(const u32x2*)(a.xlat_in16 + (size_t)(r_) * DM + (i * 64 + lane) * 4); } \
    else { _Pragma("unroll") for (int i = 0; i < 8; ++i) X[i] = *(const f32x4*)(xin_ + (i * 64 + lane) * 4); } \
    if (a.Y) { _Pragma("unroll") for (int i = 0; i < 8; ++i) YW[i] = *(const u32x2*)(a.Y + (size_t)(r_) * DM + (i * 64 + lane) * 4); } } while (0)
  if (gw < a.M) ROW_LOAD(x, xw, yw, gw);
  for (int row = gw; row < a.M; row += nw) {
    const bool lat = row < NLAT; const int bi = lat ? (row >> 12) : 8;
    float* xout = lat ? a.xlat_out + (size_t)row * DM : a.xctx_out + (size_t)(row - NLAT) * DM;
    const int rnext = row + nw;
    if (rnext < a.M) ROW_LOAD(xn, xwn, ywn, rnext);
    if (lat && a.xlat_in16) {
#pragma unroll
      for (int i = 0; i < 8; ++i) x[i] = (f32x4){bflo(xw[i].x), bfhi(xw[i].x), bflo(xw[i].y), bfhi(xw[i].y)};
    }
    if (a.Y) {
      f32x4 y[8]; float ss = 0.f;
#pragma unroll
      for (int i = 0; i < 8; ++i) { const u32x2 w = yw[i];
        y[i] = (f32x4){bflo(w.x), bfhi(w.x), bflo(w.y), bfhi(w.y)}; ss += y[i][0] * y[i][0] + y[i][1] * y[i][1] + y[i][2] * y[i][2] + y[i][3] * y[i][3]; }
      ss = wave_sum64(ss, lane); const float rstd = rsqrtf(ss * (1.0f / DM) + EPS);
      const float* gt = a.gate + (size_t)bi * 12288;
#pragma unroll
      for (int i = 0; i < 8; ++i) { const int c = (i * 64 + lane) * 4; const f32x4 gp = *(const f32x4*)(a.gpost + c), gg = *(const f32x4*)(gt + c);
        x[i] = x[i] + gg * (y[i] * rstd * gp);
        if (lat && a.xlat_out16) { u32x2 w; w.x = cvtpk(x[i][0], x[i][1]); w.y = cvtpk(x[i][2], x[i][3]); *(u32x2*)(a.xlat_out16 + (size_t)row * DM + c) = w; }
        else *(f32x4*)(xout + c) = x[i]; }
    }
    if (a.H) {
      float ss = 0.f;
#pragma unroll
      for (int i = 0; i < 8; ++i) ss += x[i][0] * x[i][0] + x[i][1] * x[i][1] + x[i][2] * x[i][2] + x[i][3] * x[i][3];
      ss = wave_sum64(ss, lane); const float rstd = rsqrtf(ss * (1.0f / DM) + EPS);
      const float* sh = a.shift + (size_t)bi * 12288; const float* sc = a.scale + (size_t)bi * 12288;
#pragma unroll
      for (int i = 0; i < 8; ++i) { const int c = (i * 64 + lane) * 4; const f32x4 gn = *(const f32x4*)(a.gnext + c), s1 = *(const f32x4*)(sh + c), s2 = *(const f32x4*)(sc + c);
        const f32x4 h = (x[i] * rstd * gn) * (s2 + 1.0f) + s1;
        u32x2 w; w.x = cvtpk(h[0], h[1]); w.y = cvtpk(h[2], h[3]); *(u32x2*)(a.H + (size_t)row * DM + c) = w; }
    }
#pragma unroll
    for (int i = 0; i < 8; ++i) { x[i] = xn[i]; yw[i] = ywn[i]; xw[i] = xwn[i]; }
  }
#undef ROW_LOAD
}

__device__ __forceinline__ void unpack8(const u32x4 w, float (&f)[8]) { f[0] = bflo(w.x); f[1] = bfhi(w.x); f[2] = bflo(w.y); f[3] = bfhi(w.y); f[4] = bflo(w.z); f[5] = bfhi(w.z); f[6] = bflo(w.w); f[7] = bfhi(w.w); }
__device__ __forceinline__ u32x4 pack8(const float (&f)[8]) { u32x4 w; w.x = cvtpk(f[0], f[1]); w.y = cvtpk(f[2], f[3]); w.z = cvtpk(f[4], f[5]); w.w = cvtpk(f[6], f[7]); return w; }
__device__ __forceinline__ void ld8f(const float* p, float (&f)[8]) { const f32x4 a = *(const f32x4*)p, b = *(const f32x4*)(p + 4); f[0] = a[0]; f[1] = a[1]; f[2] = a[2]; f[3] = a[3]; f[4] = b[0]; f[5] = b[1]; f[6] = b[2]; f[7] = b[3]; }
struct PrepRow { u32x4 ha, hb, ga, gb, q, kv; };
__device__ __forceinline__ void prep_phase(const Params& p, int l) {
  char* wsb = wsp(p);
  bf16_t* P = (bf16_t*)(wsb + WS_P);
  const float* kg = p.in[12] + l * 128; const float* qn = p.in[19] + l * 512; const float* kvn = p.in[21] + l * 256;
  const float* c128 = (const float*)(wsb + WS_ROPE); const float* s128 = c128 + 4096 * 64; const float* c64 = s128 + 4096 * 64; const float* s64 = c64 + 4096 * 32;
  const int tid_ = otid(), lane = tid_ & 63, gw = obid() * 8 + (tid_ >> 6), nw = gridDim.x * 8;
  const int hidx = lane >> 3, hj = lane & 7, gj = lane & 3, l2 = lane & 31;
  const int hcol = (hidx < 2 ? C_GK + hidx * 128 : C_WK + ((hidx - 2) & 1) * 128) + 8 * hj;
  const int gcol = (lane < 32 ? C_DK + (lane >> 2) * 64 : C_MKR) + 8 * gj;
#define PREP_LOAD(D, r_) do { const bool lat_ = (r_) < NLAT; const bf16_t* pr_ = P + (size_t)(r_) * LDP; const u32x4 z_ = {0u, 0u, 0u, 0u}; \
    const bool hact_ = hidx < 4 && (lat_ || hidx < 2), gact_ = lat_ && lane < 36; \
    D.ha = z_; D.hb = z_; D.ga = z_; D.gb = z_; D.kv = z_; \
    if (hact_) { D.ha = *(const u32x4*)(pr_ + hcol); D.hb = *(const u32x4*)(pr_ + hcol + 64); } \
    if (gact_) { D.ga = *(const u32x4*)(pr_ + gcol); D.gb = *(const u32x4*)(pr_ + gcol + 32); } \
    D.q = *(const u32x4*)(pr_ + C_MQ + 8 * lane); if (lane < 32) D.kv = *(const u32x4*)(pr_ + C_MKV + 8 * l2); } while (0)
  PrepRow cur, nxt;
  if (gw < NROWS) PREP_LOAD(cur, gw);
  for (int row = gw; row < NROWS; row += nw) {
    const bool lat = row < NLAT; const int t = row & 4095;
    bf16_t* pr = P + (size_t)row * LDP;
    const bool hact = hidx < 4 && (lat || hidx < 2), gact = lat && lane < 36;
    if (row + nw < NROWS) PREP_LOAD(nxt, row + nw);
    { float xa[8], xb[8]; unpack8(cur.ha, xa); unpack8(cur.hb, xb);
      float ss = 0.f;
#pragma unroll
      for (int e = 0; e < 8; ++e) ss += xa[e] * xa[e] + xb[e] * xb[e];
      ss += shflx(ss, 1, lane); ss += shflx(ss, 2, lane); ss += shflx(ss, 4, lane);
      if (hidx < 2) {
        const float rstd = rsqrtf(ss * (1.0f / 128.0f) + EPS);
        float ga[8], gb[8]; ld8f(kg + 8 * hj, ga); ld8f(kg + 64 + 8 * hj, gb);
#pragma unroll
        for (int e = 0; e < 8; ++e) { xa[e] *= rstd * ga[e]; xb[e] *= rstd * gb[e]; }
      }
      if (lat) {
        float c[8], sn[8]; ld8f(c128 + t * 64 + 8 * hj, c); ld8f(s128 + t * 64 + 8 * hj, sn);
#pragma unroll
        for (int e = 0; e < 8; ++e) { const float a0 = xa[e] * c[e] - xb[e] * sn[e], b0 = xb[e] * c[e] + xa[e] * sn[e]; xa[e] = a0; xb[e] = b0; }
      }
      if (hact) { *(u32x4*)(pr + hcol) = pack8(xa); *(u32x4*)(pr + hcol + 64) = pack8(xb); }
    }
    if (gact) {
      float c[8], sn[8]; ld8f(c64 + t * 32 + 8 * gj, c); ld8f(s64 + t * 32 + 8 * gj, sn);
      float xa[8], xb[8]; unpack8(cur.ga, xa); unpack8(cur.gb, xb);
#pragma unroll
      for (int e = 0; e < 8; ++e) { const float a0 = xa[e] * c[e] - xb[e] * sn[e], b0 = xb[e] * c[e] + xa[e] * sn[e]; xa[e] = a0; xb[e] = b0; }
      *(u32x4*)(pr + gcol) = pack8(xa); *(u32x4*)(pr + gcol + 32) = pack8(xb);
    }
    { float x[8]; unpack8(cur.q, x);
      float ss = 0.f;
#pragma unroll
      for (int e = 0; e < 8; ++e) ss += x[e] * x[e];
      ss = wave_sum64(ss, lane); const float rstd = rsqrtf(ss * (1.0f / 512.0f) + EPS);
      float g[8]; ld8f(qn + 8 * lane, g);
#pragma unroll
      for (int e = 0; e < 8; ++e) x[e] *= rstd * g[e];
      *(u32x4*)(pr + C_MQ + 8 * lane) = pack8(x);
      unpack8(cur.kv, x); float s2 = 0.f;
#pragma unroll
      for (int e = 0; e < 8; ++e) s2 += x[e] * x[e];
      s2 = wave_sum64(s2, lane); const float rstd2 = rsqrtf(s2 * (1.0f / 256.0f) + EPS);
      ld8f(kvn + 8 * l2, g);
#pragma unroll
      for (int e = 0; e < 8; ++e) x[e] *= rstd2 * g[e];
      if (lane < 32) *(u32x4*)(pr + C_MKV + 8 * l2) = pack8(x);
    }
    cur = nxt;
  }
#undef PREP_LOAD
}

__device__ __forceinline__ void attn_phase(const Params& p, int l, bool ctx_out, char* lds) {
  char* wsb = wsp(p);
  const bf16_t* P = (const bf16_t*)(wsb + WS_P); const bf16_t* QM = (const bf16_t*)(wsb + WS_QM); const bf16_t* KVM = (const bf16_t*)(wsb + WS_KVM);
  bf16_t* ATT = (bf16_t*)(wsb + WS_ATT);
  const float* c128 = (const float*)(wsb + WS_ROPE); const float* s128 = c128 + 4096 * 64;
  const float* c64 = (const float*)(wsb + WS_ROPE) + 2 * 4096 * 64; const float* s64 = c64 + 4096 * 32;
  const float lam = ((const float*)(wsb + WS_MISC))[l];
  const float L2E = 1.4426950408889634f;
  const int bid_ = obid();
  for (int v = bid_; v < 256; v += gridDim.x) {
    const int b = v & 7, j = v >> 3, hsel = j >> 4, qb = j & 15;
    const int nun = 8 + ((ctx_out && j < 16) ? 1 : 0);
    for (int u = 0; u < nun; ++u) {
      int type, head, qrow0, NT; bool isctx = (u == 8);
      if (!isctx) { type = u >> 1; head = (u & 1) * 2 + hsel; qrow0 = b * SEQ + qb * 256; NT = 68; }
      else { type = j >> 2; head = j & 3; qrow0 = NLAT + b * CTXL; NT = 4; }
      AttnArgs a;
      a.crow0 = NLAT + b * CTXL; a.lrow0 = b * SEQ; a.NT = NT; a.ldo = DM; a.tmp = (float*)(wsb + WS_TMP) + (size_t)bid_ * 256 * 128;
      a.lam = lam; a.postmul = p.one_minus_lam_init[l]; a.subln = p.in[17] + l * 128; a.sinkl2 = 0.f; a.q0 = 0; a.kstart = 0; a.rc = c64; a.rs = s64; a.tq0 = isctx ? -1 : qb * 256; a.qgain = p.in[11] + l * 128;
      a.K2 = nullptr; a.ldk2 = 0;
      if (type == 0) {
        const int g = head >> 1; const float sc = 0.08838834764831845f;
        a.Q = P + (size_t)qrow0 * LDP + C_GQ + head * 128; a.ldq = LDP; a.K = P + C_GK + g * 128; a.ldk = LDP; a.V = P + C_GV + g * 128; a.ldv = LDP;
        a.C = sc * L2E; a.thrs = 8.f / sc; a.O = ATT + (size_t)qrow0 * DM + head * 128; a.rc = c128; a.rs = s128;
        attn_unit<128, 0, 2, 1>(a, lds);
      } else if (type == 1) {
        const float sc = 0.125f;
        a.Q = P + (size_t)qrow0 * LDP + C_DQ + head * 128; a.ldq = LDP; a.K = P + C_DK + head * 128; a.ldk = LDP; a.V = P + C_DV + head * 128; a.ldv = LDP;
        a.C = sc * L2E; a.thrs = 8.f / sc; a.O = ATT + (size_t)qrow0 * DM + 512 + head * 128;
        attn_unit<64, 1, 2, 2>(a, lds);
        a.Q += 64; a.K += 64;
        attn_unit<64, 2, 2, 2>(a, lds);
      } else if (type == 2) {
        const int g = head >> 1; const float sc = 0.08838834764831845f;
        a.Q = P + (size_t)qrow0 * LDP + C_WQ + head * 128; a.ldq = LDP; a.K = P + C_WK + g * 128; a.ldk = LDP; a.V = P + C_WV + g * 128; a.ldv = LDP;
        a.C = sc * L2E; a.thrs = 8.f / sc; a.O = ATT + (size_t)qrow0 * DM + 1024 + head * 128;
        a.sinkl2 = p.in[18][l * 4 + head] * L2E; a.rc = c128; a.rs = s128;
        if (!isctx) { const int q0 = qb * 256; const int ks = (qb == 0) ? 0 : q0 - 128; const int ke = (qb == 15) ? SEQ : q0 + 384;
          a.q0 = __builtin_amdgcn_readfirstlane(q0); a.kstart = __builtin_amdgcn_readfirstlane(ks); a.lrow0 = __builtin_amdgcn_readfirstlane(b * SEQ + ks); a.NT = __builtin_amdgcn_readfirstlane(4 + (ke - ks) / 64); }
        attn_unit<128, 3, 2, 2>(a, lds);
      } else {
        const float sc = 0.07216878364870322f;
        a.Q = QM + (size_t)qrow0 * LDQM + head * 192; a.ldq = LDQM; a.K = KVM + head * 256; a.ldk = LDKVM; a.K2 = P + C_MKR; a.ldk2 = LDP; a.V = KVM + head * 256 + 128; a.ldv = LDKVM;
        a.C = sc * L2E; a.thrs = 8.f / sc; a.O = ATT + (size_t)qrow0 * DM + 1536 + head * 128;
        attn_unit<192, 0, 1, 2>(a, lds);
      }
    }
  }
}

__device__ __forceinline__ char* wsp(const Params& p) { char* w = p.ws; asm volatile("" : "+s"(w)); return w; }
__global__ void __launch_bounds__(512) fwd_megakernel(Params p) {
  extern __shared__ __attribute__((aligned(16))) char shm[];
  cg::grid_group grid = cg::this_grid();
  LAS unsigned char* ldsg = (LAS unsigned char*)shm;
  volatile LAS unsigned* xst = (volatile LAS unsigned*)(ldsg + pg8::STAGE_BYTES);
  if (threadIdx.x == 0) { xst[0] = 0u; xst[1] = 0u; }
  __syncthreads();
  const XcdBarrier xbar = xcd_barrier_post((unsigned*)(p.ws + WS_BAR), xst);
  phase0(p, shm);
  grid.sync();
  { char* ws = wsp(p); const float* mod = (const float*)(ws + WS_MOD);
    RowArgs a; a.xlat_in = p.in[0]; a.xctx_in = p.in[2]; a.xlat_out = p.out; a.xctx_out = (float*)(ws + WS_XC); a.xlat_in16 = nullptr; a.xlat_out16 = nullptr; a.Y = nullptr; a.gpost = nullptr; a.gate = nullptr;
    a.H = (bf16_t*)(ws + WS_H); a.gnext = p.in[6]; a.shift = mod + 0 * DM; a.scale = mod + 1 * DM; a.M = NROWS; a.r0 = 0; a.vb = obid(); a.vG = gridDim.x; row_phase(a); }
  xcd_barrier(xbar);
  for (int l0 = 0; l0 < 2; ++l0) {
    int l = l0; asm volatile("" : "+s"(l));
    const bool last = (l == 1);
    const int Mr = last ? NLAT : NROWS;
    { char* ws = wsp(p); pg8::StaticOrder S; pg8::Gemm g{(const bf16_t*)(ws + WS_H), (const bf16_t*)(ws + WS_W + (size_t)l * SZ_WL + OFF_WIN), NROWS, LDP, DM, DM};
      S.init(g.M, g.N, gridDim.x, obid()); pg8::EpiBf16 e{(bf16_t*)(ws + WS_P), LDP}; pg8::gemm_phase(ldsg, g, S, e); }
    xcd_barrier(xbar);
    prep_phase(p, l);
    xcd_barrier(xbar);
    { char* ws = wsp(p); pg8::StaticOrder S; pg8::Gemm g{(const bf16_t*)(ws + WS_P) + C_MQ, (const bf16_t*)(ws + WS_W + (size_t)l * SZ_WL + OFF_WUQ), NROWS, 768, 512, LDP};
      S.init(g.M, g.N, gridDim.x, obid()); pg8::EpiBf16 e{(bf16_t*)(ws + WS_QM), LDQM}; pg8::gemm_phase(ldsg, g, S, e); }
    { char* ws = wsp(p); pg8::StaticOrder S; pg8::Gemm g{(const bf16_t*)(ws + WS_P) + C_MKV, (const bf16_t*)(ws + WS_W + (size_t)l * SZ_WL + OFF_WUKV), NROWS, 1024, 256, LDP};
      S.init(g.M, g.N, gridDim.x, obid()); pg8::EpiBf16 e{(bf16_t*)(ws + WS_KVM), LDKVM}; pg8::gemm_phase(ldsg, g, S, e); }
    xcd_barrier(xbar);
    attn_phase(p, l, !last, shm);
    xcd_barrier(xbar);
    const bool cx = !last; const int bid = obid(), G = gridDim.x;
    { char* ws = wsp(p); pg8::StaticOrder S; pg8::Gemm g{(const bf16_t*)(ws + WS_ATT), (const bf16_t*)(ws + WS_W + (size_t)l * SZ_WL + OFF_WOUT), NLAT, DM, DM, DM};
      S.init(g.M, g.N, G, bid); pg8::EpiBf16 e{(bf16_t*)(ws + WS_Y), DM}; pg8::gemm_phase(ldsg, g, S, e); }
    xcd_barrier(xbar);
    if (cx && bid < 64) {
      char* ws = wsp(p); pg8::StaticOrder S; pg8::Gemm g{(const bf16_t*)(ws + WS_ATT) + (size_t)NLAT * DM, (const bf16_t*)(ws + WS_W + (size_t)l * SZ_WL + OFF_WOUT), NCTX, DM, DM, DM};
      S.init(g.M, g.N, 64, bid); pg8::EpiBf16 e{(bf16_t*)(ws + WS_Y) + (size_t)NLAT * DM, DM}; pg8::gemm_phase(ldsg, g, S, e);
    } else {
      {
        char* ws = wsp(p); const float* modl = (const float*)(ws + WS_MOD) + (size_t)l * 9 * 12288;
        RowArgs a; a.xlat_in = p.in[0]; a.xctx_in = (l == 0) ? p.in[2] : (const float*)(ws + WS_XC); a.xlat_out = p.out; a.xctx_out = (float*)(ws + WS_XC);
        a.xlat_in16 = (l == 0) ? nullptr : (const bf16_t*)p.out; a.xlat_out16 = (bf16_t*)(ws + WS_ATT);
        a.Y = (const bf16_t*)(ws + WS_Y); a.gpost = p.in[7] + l * DM; a.gate = modl + 2 * DM;
        a.H = (bf16_t*)(ws + WS_H); a.gnext = p.in[8] + l * DM; a.shift = modl + 3 * DM; a.scale = modl + 4 * DM;
        a.r0 = 0; a.M = NLAT; a.vb = cx ? bid - 64 : bid; a.vG = cx ? G - 64 : G; row_phase(a);
      }
    }
    xcd_barrier(xbar);
    if (cx) {
      char* ws = wsp(p); const float* modl = (const float*)(ws + WS_MOD) + (size_t)l * 9 * 12288;
      RowArgs a; a.xlat_in = p.in[0]; a.xctx_in = p.in[2]; a.xlat_out = p.out; a.xctx_out = (float*)(ws + WS_XC); a.xlat_in16 = nullptr; a.xlat_out16 = nullptr;
      a.Y = (const bf16_t*)(ws + WS_Y); a.gpost = p.in[7] + l * DM; a.gate = modl + 2 * DM;
      a.H = (bf16_t*)(ws + WS_H); a.gnext = p.in[8] + l * DM; a.shift = modl + 3 * DM; a.scale = modl + 4 * DM;
      a.r0 = NLAT; a.M = NROWS; a.vb = bid; a.vG = G; row_phase(a);
      xcd_barrier(xbar);
    }
    { char* ws = wsp(p); pg8::StaticOrder S; pg8::Gemm g{(const bf16_t*)(ws + WS_H), (const bf16_t*)(ws + WS_W + (size_t)l * SZ_WL + OFF_WGU), Mr, 2 * DFF, DM, DM};
      S.init(g.M, g.N, G, bid); pg8::EpiSwiGLU e{(bf16_t*)(ws + WS_U), DFF}; pg8::gemm_phase(ldsg, g, S, e); }
    xcd_barrier(xbar);
    { char* ws = wsp(p); pg8::StaticOrder S; pg8::Gemm g{(const bf16_t*)(ws + WS_U), (const bf16_t*)(ws + WS_W + (size_t)l * SZ_WL + OFF_WDN), NLAT, DM, DFF, DFF};
      S.init(g.M, g.N, G, bid); pg8::EpiBf16 e{(bf16_t*)(ws + WS_H), DM}; pg8::gemm_phase(ldsg, g, S, e); }
    xcd_barrier(xbar);
    if (cx && bid < 64) {
      char* ws = wsp(p); pg8::StaticOrder S; pg8::Gemm g{(const bf16_t*)(ws + WS_U) + (size_t)NLAT * DFF, (const bf16_t*)(ws + WS_W + (size_t)l * SZ_WL + OFF_WDN), NCTX, DM, DFF, DFF};
      S.init(g.M, g.N, 64, bid); pg8::EpiBf16 e{(bf16_t*)(ws + WS_H) + (size_t)NLAT * DM, DM}; pg8::gemm_phase(ldsg, g, S, e);
    } else {
      char* ws = wsp(p); const float* modl = (const float*)(ws + WS_MOD) + (size_t)l * 9 * 12288;
      RowArgs a; a.xlat_in = p.out; a.xctx_in = (const float*)(ws + WS_XC); a.xlat_out = p.out; a.xctx_out = (float*)(ws + WS_XC);
      a.xlat_in16 = (const bf16_t*)(ws + WS_ATT); a.xlat_out16 = last ? nullptr : (bf16_t*)p.out;
      a.Y = (const bf16_t*)(ws + WS_H); a.gpost = p.in[9] + l * DM; a.gate = modl + 5 * DM;
      a.H = last ? nullptr : (bf16_t*)(ws + WS_H); a.gnext = last ? nullptr : p.in[6] + (l + 1) * DM;
      a.shift = last ? nullptr : modl + 9 * 12288 + 0 * DM; a.scale = last ? nullptr : modl + 9 * 12288 + 1 * DM;
      a.r0 = 0; a.M = NLAT; a.vb = cx ? bid - 64 : bid; a.vG = cx ? G - 64 : G; row_phase(a);
    }
    if (cx) {
      xcd_barrier(xbar);
      char* ws = wsp(p); const float* modl = (const float*)(ws + WS_MOD) + (size_t)l * 9 * 12288;
      RowArgs a; a.xlat_in = p.out; a.xctx_in = (const float*)(ws + WS_XC); a.xlat_out = p.out; a.xctx_out = (float*)(ws + WS_XC); a.xlat_in16 = nullptr; a.xlat_out16 = nullptr;
      a.Y = (const bf16_t*)(ws + WS_H); a.gpost = p.in[9] + l * DM; a.gate = modl + 5 * DM;
      a.H = (bf16_t*)(ws + WS_H); a.gnext = p.in[6] + (l + 1) * DM; a.shift = modl + 9 * 12288 + 0 * DM; a.scale = modl + 9 * 12288 + 1 * DM;
      a.r0 = NLAT; a.M = NROWS; a.vb = bid; a.vG = G; row_phase(a);
    }
    if (!last) xcd_barrier(xbar);
  }
}

extern "C" void kernel_launch(void* const* d_in, const int* in_sizes, int n_in, void* d_out, int out_size, void* d_ws, size_t ws_size, hipStream_t stream) {
  constexpr size_t kDynLds = pg8::STAGE_BYTES + 64;
  static int ready = 0;
  if (!ready) {
    if (n_in != 27 || ws_size < WS_END) { fprintf(stderr, "kernel_launch: unexpected n_in %d / ws_size %zu (need %zu)\n", n_in, ws_size, (size_t)WS_END); return; }
    if (hipFuncSetAttribute((const void*)fwd_megakernel, hipFuncAttributeMaxDynamicSharedMemorySize, (int)kDynLds) != hipSuccess) { fprintf(stderr, "kernel_launch: LDS attribute failed\n"); return; }
    ready = 1;
  }
  Params p{};
  for (int i = 0; i < 27; ++i) p.in[i] = (const float*)d_in[i];
  p.out = (float*)d_out; p.ws = (char*)d_ws;
  for (int l = 0; l < 2; ++l) { const float li = (float)(0.8 - 0.6 * exp(-0.3 * (double)l)); p.lam_init[l] = li; p.one_minus_lam_init[l] = 1.0f - li; }
  if (hipMemsetAsync((char*)d_ws + WS_BAR, 0, 16384, stream) != hipSuccess) { fprintf(stderr, "kernel_launch: memset of barrier words failed\n"); return; }
  void* args[] = {&p};
  hipError_t e = hipLaunchCooperativeKernel((void*)fwd_megakernel, dim3(256), dim3(512), args, kDynLds, stream);
  if (e != hipSuccess) fprintf(stderr, "cooperative launch failed: %s\n", hipGetErrorString(e));
}
```

```cpp
#include <hip/hip_runtime.h>
#include <hip/hip_cooperative_groups.h>
#include <cstdio>
#include <cmath>
namespace cg = cooperative_groups;

typedef unsigned short bf16_t;
typedef short bf16x8 __attribute__((ext_vector_type(8)));
typedef short s16x4 __attribute__((ext_vector_type(4)));
typedef float f32x2 __attribute__((ext_vector_type(2)));
typedef float f32x4 __attribute__((ext_vector_type(4)));
typedef float f32x16 __attribute__((ext_vector_type(16)));
typedef unsigned u32x2 __attribute__((ext_vector_type(2)));
typedef unsigned u32x4 __attribute__((ext_vector_type(4)));
#define LAS __attribute__((address_space(3)))

constexpr int NLAT = 32768, NCTX = 2048, NROWS = NLAT + NCTX, DM = 2048, SEQ = 4096, CTXL = 256, NB = 8;
constexpr int INC = 4416, LDP = 4608, DFF = 5632, LDQM = 768, LDKVM = 1024;
constexpr float EPS = 1e-6f;
constexpr int C_GQ = 0, C_GK = 512, C_GV = 768, C_DQ = 1024, C_DK = 1536, C_DV = 2048, C_WQ = 2560, C_WK = 3072, C_WV = 3328, C_MQ = 3584, C_MKV = 4096, C_MKR = 4352;

constexpr size_t al256(size_t x) { return (x + 255) / 256 * 256; }
constexpr size_t SZ_WIN = (size_t)LDP * DM * 2, SZ_WUQ = (size_t)768 * 512 * 2, SZ_WUKV = (size_t)1024 * 256 * 2, SZ_WOUT = (size_t)DM * DM * 2,
                 SZ_WGU = (size_t)2 * DFF * DM * 2, SZ_WDN = (size_t)DM * DFF * 2;
constexpr size_t OFF_WIN = 0, OFF_WUQ = OFF_WIN + SZ_WIN, OFF_WUKV = OFF_WUQ + SZ_WUQ, OFF_WOUT = OFF_WUKV + SZ_WUKV, OFF_WGU = OFF_WOUT + SZ_WOUT,
                 OFF_WDN = OFF_WGU + SZ_WGU, SZ_WL = OFF_WDN + SZ_WDN;
constexpr size_t WS_W = 0;
constexpr size_t WS_MOD = al256(WS_W + 2 * SZ_WL);
constexpr size_t WS_ROPE = al256(WS_MOD + (size_t)2 * 9 * 12288 * 4);
constexpr size_t SZ_R128 = (size_t)4096 * 64 * 4, SZ_R64 = (size_t)4096 * 32 * 4;
constexpr size_t WS_MISC = al256(WS_ROPE + 2 * SZ_R128 + 2 * SZ_R64);
constexpr size_t WS_H = al256(WS_MISC + 256);
constexpr size_t WS_P = al256(WS_H + (size_t)NROWS * DM * 2);
constexpr size_t WS_QM = al256(WS_P + (size_t)NROWS * LDP * 2);
constexpr size_t WS_KVM = al256(WS_QM + (size_t)NROWS * LDQM * 2);
constexpr size_t WS_PEND = al256(WS_KVM + (size_t)NROWS * LDKVM * 2);
constexpr size_t WS_ATT = WS_PEND;
constexpr size_t WS_XC = al256(WS_ATT + (size_t)NROWS * DM * 2);
constexpr size_t WS_TMP = al256(WS_XC + (size_t)NCTX * DM * 4);
constexpr size_t WS_BAR = al256(WS_TMP + (size_t)256 * 256 * 128 * 4);
constexpr size_t WS_END = WS_BAR + 16384;
constexpr size_t WS_Y = WS_P;
constexpr size_t WS_U = WS_P;
static_assert((size_t)NROWS * DFF * 2 <= WS_PEND - WS_P, "U must fit in P region");

struct Params {
  const float* in[27];
  float* out;
  char* ws;
  float lam_init[2];
  float one_minus_lam_init[2];
};

__device__ __forceinline__ char* wsp(const Params& p);
__device__ __forceinline__ int otid() { int t = threadIdx.x; asm volatile("" : "+v"(t)); return t; }
__device__ __forceinline__ int obid() { int b = blockIdx.x; asm volatile("" : "+s"(b)); return b; }
__device__ __forceinline__ unsigned cvtpk(float lo, float hi) { unsigned r; asm volatile("v_cvt_pk_bf16_f32 %0, %1, %2" : "=v"(r) : "v"(lo), "v"(hi)); return r; }
__device__ __forceinline__ float bflo(unsigned u) { return __uint_as_float(u << 16); }
__device__ __forceinline__ float bfhi(unsigned u) { return __uint_as_float(u & 0xffff0000u); }
__device__ __forceinline__ float shflx(float v, int m, int lane) { return __int_as_float(__builtin_amdgcn_ds_bpermute((lane ^ m) << 2, __float_as_int(v))); }
__device__ __forceinline__ float wave_sum64(float v, int lane) {
  v += shflx(v, 1, lane); v += shflx(v, 2, lane); v += shflx(v, 4, lane); v += shflx(v, 8, lane); v += shflx(v, 16, lane); v += shflx(v, 32, lane); return v; }
__device__ __forceinline__ float half_sum32(float v, int lane) {
  v += shflx(v, 1, lane); v += shflx(v, 2, lane); v += shflx(v, 4, lane); v += shflx(v, 8, lane); v += shflx(v, 16, lane); return v; }


#define XB_TMO      128
#define XB_XCNT(j)  (256  + 64 * (j))
#define XB_XSUB(j)  (1280 + 64 * (j))
#define XB_XGEN(j)  (2304 + 64 * (j))
#define XB_TOP      3328
#define XB_TOPGEN   3392
#define XCD_BAR_WORDS 3456
#define XB_SPIN_CAP (1u << 18)
__device__ __forceinline__ unsigned xb_ld(unsigned* p)              { return __hip_atomic_load(p, __ATOMIC_RELAXED, __HIP_MEMORY_SCOPE_AGENT); }
__device__ __forceinline__ unsigned xb_add(unsigned* p, unsigned v) { return __hip_atomic_fetch_add(p, v, __ATOMIC_RELAXED, __HIP_MEMORY_SCOPE_AGENT); }
__device__ __forceinline__ unsigned xb_xcc_id() { return (unsigned)__builtin_amdgcn_s_getreg((3 << 11) | 20) & 0xFu; }
#define XB_SPIN(cond, bar) do { unsigned _sp = 0; while (cond) { __builtin_amdgcn_s_sleep(1); \
    if ((++_sp & 255u) == 0u) { if (xb_ld(&(bar)[XB_TMO])) break; if (_sp > XB_SPIN_CAP) { atomicAdd(&(bar)[XB_TMO], 1u); break; } } } } while (0)
struct XcdBarrier { unsigned* bar; unsigned x; volatile LAS unsigned* st; };
__device__ __forceinline__ XcdBarrier xcd_barrier_post(unsigned* bar, volatile LAS unsigned* st) {
  XcdBarrier b; b.bar = bar; b.x = (unsigned)__builtin_amdgcn_readfirstlane((int)xb_xcc_id()); b.st = st;
  if (threadIdx.x == 0) (void)xb_add(&bar[XB_XCNT(b.x)], 1u);
  return b;
}
__device__ __forceinline__ void xcd_barrier_complete(unsigned* bar, unsigned x, unsigned& nloc, unsigned& nx) {
  const unsigned G = gridDim.x * gridDim.y * gridDim.z;
  unsigned sum, cnt, mine, sp = 0u;
  for (;;) {
    sum = 0u; cnt = 0u; mine = 0u;
#pragma unroll
    for (unsigned j = 0; j < 16; ++j) { const unsigned c = xb_ld(&bar[XB_XCNT(j)]); sum += c; cnt += (c > 0u) ? 1u : 0u; mine = (j == x) ? c : mine; }
    if (sum == G) break;
    __builtin_amdgcn_s_sleep(1);
    if ((++sp & 255u) == 0u) { if (xb_ld(&bar[XB_TMO])) break; if (sp > XB_SPIN_CAP) { atomicAdd(&bar[XB_TMO], 1u); break; } }
  }
  nloc = mine > 0u ? mine : 1u; nx = cnt > 0u ? cnt : 1u;
}
__device__ __forceinline__ void xcd_barrier(const XcdBarrier& b) {
  asm volatile("s_waitcnt vmcnt(0)" ::: "memory");
  __syncthreads();
  if (threadIdx.x == 0) {
    unsigned* bar = b.bar;
    const unsigned bx = (unsigned)__builtin_amdgcn_readfirstlane((int)xb_xcc_id());
    __builtin_amdgcn_s_waitcnt(0);
    unsigned nloc = b.st[0], nx = b.st[1];
    if (nloc == 0u) { xcd_barrier_complete(bar, bx, nloc, nx); b.st[0] = nloc; b.st[1] = nx; }
    const unsigned old = xb_add(&bar[XB_XSUB(bx)], 1u);
    const unsigned gen = old / nloc;
    if (old + 1u == (gen + 1u) * nloc) {
      __builtin_amdgcn_fence(__ATOMIC_RELEASE, "agent");
      asm volatile("s_waitcnt vmcnt(0)" ::: "memory");
      const unsigned og = xb_add(&bar[XB_TOP], 1u);
      const unsigned tg = og / nx;
      if (og + 1u == (tg + 1u) * nx) xb_add(&bar[XB_TOPGEN], 1u);
      else XB_SPIN(xb_ld(&bar[XB_TOPGEN]) == tg, bar);
      __builtin_amdgcn_fence(__ATOMIC_ACQUIRE, "agent");
      xb_add(&bar[XB_XGEN(bx)], 1u);
      asm volatile("s_waitcnt vmcnt(0)" ::: "memory");
    } else {
      XB_SPIN(xb_ld(&bar[XB_XGEN(bx)]) == gen, bar);
      __builtin_amdgcn_fence(__ATOMIC_ACQUIRE, "agent");
      asm volatile("s_waitcnt vmcnt(0)" ::: "memory");
    }
  }
  __syncthreads();
}

namespace pg8 {
constexpr int BM = 256, BK = 64, HALF = 128, HTB = HALF * BK * 2, STAGE_BYTES = 8 * HTB, NXCD = 8, WGM = 8;
__device__ __forceinline__ int lds_byte(int r, int c) { const int st = (r >> 4) * 2 + (c >> 5), rr = r & 15, cc = c & 31, ob = rr * 64 + cc * 2; return st * 1024 + (ob ^ (((ob >> 9) & 1) << 5)); }
__device__ __forceinline__ void stage_rc(int b, int& R, int& C) { const int st = b / 1024, sb = b % 1024, swz = sb ^ (((sb >> 9) & 1) << 5); R = (st >> 1) * 16 + swz / 64; C = (st & 1) * 32 + (swz % 64) / 2; }
__device__ __forceinline__ int perm32(int rho) { const int n = rho >> 4, i = rho & 15; return 8 * (i >> 2) + 4 * n + (i & 3); }
struct Unit { int pm, pn; };
struct Gemm { const bf16_t* A; const bf16_t* Bt; int M, N, K, lda; };
struct StaticOrder {
  int nM, nN, nwg, G, c;
  __device__ void init(int M, int N, int G_, int c_) { nM = M / BM; nN = N / BM; nwg = nM * nN; G = G_; c = c_; }
  __device__ bool next(int i, Unit& u) const {
    const long L = (long)i * G + c; if (L >= nwg) return false;
    int wgid = (int)L; { const int q = nwg / NXCD, r = nwg % NXCD, xcd = wgid % NXCD, off = wgid / NXCD; wgid = (xcd < r ? xcd * (q + 1) : r * (q + 1) + (xcd - r) * q) + off; }
    const int nig = WGM * nN, gid = wgid / nig, fm = gid * WGM, gsz = (nM - fm) < WGM ? (nM - fm) : WGM;
    u.pm = fm + ((wgid % nig) % gsz); u.pn = (wgid % nig) / gsz; return true;
  }
};
struct EpiBf16 {
  bf16_t* O; int ldc;
  __device__ __forceinline__ void operator()(const f32x4 (&acc)[2][2][4][2], const Unit& u, int wr, int wc, int fr, int fq) const {
    const int row0 = u.pm * BM + wr * 64 + fr, col0 = u.pn * BM + wc * 32 + 8 * fq;
#pragma unroll
    for (int ai = 0; ai < 2; ++ai)
#pragma unroll
      for (int m = 0; m < 4; ++m) { bf16_t* rowp = O + (size_t)(row0 + ai * HALF + m * 16) * ldc + col0;
#pragma unroll
        for (int bj = 0; bj < 2; ++bj) { const f32x4 v0 = acc[ai][bj][m][0], v1 = acc[ai][bj][m][1];
          u32x4 w; w.x = cvtpk(v0[0], v0[1]); w.y = cvtpk(v0[2], v0[3]); w.z = cvtpk(v1[0], v1[1]); w.w = cvtpk(v1[2], v1[3]);
          *(u32x4*)(rowp + bj * HALF) = w; } }
  }
};
__device__ __forceinline__ float swiglu1(float g, float u) { return g * __builtin_amdgcn_rcpf(1.0f + __builtin_amdgcn_exp2f(-1.4426950408889634f * g)) * u; }
struct EpiSwiGLU {
  bf16_t* O; int ldc;
  __device__ __forceinline__ void operator()(const f32x4 (&acc)[2][2][4][2], const Unit& u, int wr, int wc, int fr, int fq) const {
    const int row0 = u.pm * BM + wr * 64 + fr, col0 = u.pn * HALF + wc * 32 + 8 * fq;
#pragma unroll
    for (int ai = 0; ai < 2; ++ai)
#pragma unroll
      for (int m = 0; m < 4; ++m) { bf16_t* rowp = O + (size_t)(row0 + ai * HALF + m * 16) * ldc + col0;
        const f32x4 g0 = acc[ai][0][m][0], g1 = acc[ai][0][m][1], u0 = acc[ai][1][m][0], u1 = acc[ai][1][m][1];
        u32x4 w; w.x = cvtpk(swiglu1(g0[0], u0[0]), swiglu1(g0[1], u0[1])); w.y = cvtpk(swiglu1(g0[2], u0[2]), swiglu1(g0[3], u0[3]));
        w.z = cvtpk(swiglu1(g1[0], u1[0]), swiglu1(g1[1], u1[1])); w.w = cvtpk(swiglu1(g1[2], u1[2]), swiglu1(g1[3], u1[3]));
        *(u32x4*)rowp = w; }
  }
};

template <class Epi>
__device__ __forceinline__ void gemm_phase(LAS unsigned char* lds, const Gemm g, const StaticOrder& S, const Epi& E) {
  int tid = threadIdx.x; asm volatile("" : "+v"(tid));
  const int wid = __builtin_amdgcn_readfirstlane(tid >> 6), lane = tid & 63, wr = wid >> 2, wc = wid & 3, fr = lane & 15, fq = lane >> 4;
  const int K = g.K, nt = K / BK, lda = g.lda;
  unsigned voffA[2], voffB[2];
#pragma unroll
  for (int i = 0; i < 2; ++i) { int R, C; stage_rc(tid * 16 + i * 8192, R, C); const int Rb = (R & ~31) + perm32(R & 31);
    voffA[i] = (unsigned)(R * lda + C) * 2u; voffB[i] = (unsigned)(Rb * K + C) * 2u; }
  const size_t kstep = (size_t)(BK * 2);
  const size_t hstepA = (size_t)HALF * lda * 2, tstepA = 2 * hstepA;
  const size_t hstepB = (size_t)HALF * K * 2, tstepB = 2 * hstepB;
  const unsigned ldsw = (unsigned)wid * 1024u;
  const int aoff = lds_byte(wr * 64 + fr, fq * 8), boff = lds_byte(wc * 32 + fr, fq * 8);
#define PG8_SA(b, h) (((b) * 2 + (h)) * HTB)
#define PG8_SB(b, h) ((4 + (b) * 2 + (h)) * HTB)
#define PG8_STAGE(bufoff, gbase, voff) do { _Pragma("unroll") for (int _i = 0; _i < 2; ++_i) \
    __builtin_amdgcn_global_load_lds((const unsigned*)((const char*)(gbase) + (voff)[_i]), (LAS unsigned*)(lds + (bufoff) + ldsw + _i * 8192), 16, 0, 0); } while (0)
#define PG8_LDA(dst, b, h) do { _Pragma("unroll") for (int m = 0; m < 4; ++m) _Pragma("unroll") for (int k = 0; k < 2; ++k) dst[m][k] = *(const LAS bf16x8*)(lds + PG8_SA(b, h) + aoff + m * 2048 + k * 1024); } while (0)
#define PG8_LDB(dst, b, h) do { _Pragma("unroll") for (int n = 0; n < 2; ++n) _Pragma("unroll") for (int k = 0; k < 2; ++k) dst[n][k] = *(const LAS bf16x8*)(lds + PG8_SB(b, h) + boff + n * 2048 + k * 1024); } while (0)
#define PG8_MMA(ai, bj, At, Bt) do { __builtin_amdgcn_s_setprio(1); _Pragma("unroll") for (int m = 0; m < 4; ++m) _Pragma("unroll") for (int n = 0; n < 2; ++n) _Pragma("unroll") for (int k = 0; k < 2; ++k) \
    acc[ai][bj][m][n] = __builtin_amdgcn_mfma_f32_16x16x32_bf16(Bt[n][k], At[m][k], acc[ai][bj][m][n], 0, 0, 0); __builtin_amdgcn_s_setprio(0); } while (0)
#define PG8_WAIT_V(n) asm volatile("s_waitcnt vmcnt(" #n ")" ::: "memory")
#define PG8_WAIT_L(n) asm volatile("s_waitcnt lgkmcnt(" #n ")" ::: "memory")
#define PG8_BAR __builtin_amdgcn_s_barrier()
#define PG8_SCHED __builtin_amdgcn_sched_barrier(0)
  Unit cur, nxt; int ui = 0;
  if (!S.next(0, cur)) return;
  f32x4 acc[2][2][4][2];
#pragma unroll
  for (int a = 0; a < 2; ++a)
#pragma unroll
    for (int b = 0; b < 2; ++b)
#pragma unroll
      for (int m = 0; m < 4; ++m)
#pragma unroll
        for (int n = 0; n < 2; ++n) acc[a][b][m][n] = (f32x4){0.f, 0.f, 0.f, 0.f};
  bf16x8 At[4][2], B0[2][2], B1[2][2];
  const char* cA = (const char*)g.A + (size_t)cur.pm * tstepA; const char* cB = (const char*)g.Bt + (size_t)cur.pn * tstepB;
  PG8_STAGE(PG8_SB(0, 0), cB, voffB); PG8_STAGE(PG8_SA(0, 0), cA, voffA); PG8_STAGE(PG8_SB(0, 1), cB + hstepB, voffB); PG8_STAGE(PG8_SA(0, 1), cA + hstepA, voffA);
  if (wr == 1) PG8_BAR;
  PG8_WAIT_V(4); PG8_BAR;
  PG8_STAGE(PG8_SB(1, 0), cB + kstep, voffB); PG8_STAGE(PG8_SA(1, 0), cA + kstep, voffA); PG8_STAGE(PG8_SB(1, 1), cB + hstepB + kstep, voffB);
  PG8_WAIT_V(6); PG8_BAR;
  for (;;) {
    const bool has_next = S.next(ui + 1, nxt);
    const char* nA = has_next ? (const char*)g.A + (size_t)nxt.pm * tstepA : cA; const char* nB = has_next ? (const char*)g.Bt + (size_t)nxt.pn * tstepB : cB;
    for (int t = 0; t < nt; t += 2) {
      const bool last = (t == nt - 2);
      const char* a1 = cA + (size_t)(t + 1) * kstep;
      const char* a2 = last ? nA : cA + (size_t)(t + 2) * kstep; const char* b2 = last ? nB : cB + (size_t)(t + 2) * kstep;
      const char* a3 = a2 + kstep; const char* b3 = b2 + kstep;
      PG8_LDB(B0, 0, 0); PG8_SCHED; PG8_LDA(At, 0, 0); PG8_STAGE(PG8_SA(1, 1), a1 + hstepA, voffA);
      PG8_WAIT_L(8); PG8_BAR; PG8_WAIT_L(0); PG8_MMA(0, 0, At, B0); PG8_BAR; PG8_SCHED;
      PG8_LDB(B1, 0, 1); PG8_STAGE(PG8_SB(0, 0), b2, voffB);
      PG8_BAR; PG8_WAIT_L(0); PG8_MMA(0, 1, At, B1); PG8_BAR;
      PG8_LDA(At, 0, 1); PG8_STAGE(PG8_SA(0, 0), a2, voffA);
      PG8_BAR; PG8_WAIT_L(0); PG8_MMA(1, 0, At, B0); PG8_BAR; PG8_SCHED;
      PG8_STAGE(PG8_SB(0, 1), b2 + hstepB, voffB);
      PG8_WAIT_V(6); PG8_BAR; PG8_MMA(1, 1, At, B1); PG8_BAR;
      PG8_LDB(B0, 1, 0); PG8_SCHED; PG8_LDA(At, 1, 0); PG8_STAGE(PG8_SA(0, 1), a2 + hstepA, voffA);
      PG8_WAIT_L(8); PG8_BAR; PG8_WAIT_L(0); PG8_MMA(0, 0, At, B0); PG8_BAR; PG8_SCHED;
      PG8_LDB(B1, 1, 1); PG8_STAGE(PG8_SB(1, 0), b3, voffB);
      PG8_BAR; PG8_WAIT_L(0); PG8_MMA(0, 1, At, B1); PG8_BAR;
      PG8_LDA(At, 1, 1); PG8_STAGE(PG8_SA(1, 0), a3, voffA);
      PG8_BAR; PG8_WAIT_L(0); PG8_MMA(1, 0, At, B0); PG8_BAR; PG8_SCHED;
      PG8_STAGE(PG8_SB(1, 1), b3 + hstepB, voffB);
      PG8_WAIT_V(6); PG8_BAR; PG8_MMA(1, 1, At, B1); PG8_BAR;
    }
    E(acc, cur, wr, wc, fr, fq);
    if (!has_next) break;
#pragma unroll
    for (int a = 0; a < 2; ++a)
#pragma unroll
      for (int b = 0; b < 2; ++b)
#pragma unroll
        for (int m = 0; m < 4; ++m)
#pragma unroll
          for (int n = 0; n < 2; ++n) acc[a][b][m][n] = (f32x4){0.f, 0.f, 0.f, 0.f};
    cur = nxt; cA = nA; cB = nB; ++ui;
  }
  PG8_WAIT_V(0);
  if (wr == 0) PG8_BAR;
  PG8_BAR;
#undef PG8_SA
#undef PG8_SB
#undef PG8_STAGE
#undef PG8_LDA
#undef PG8_LDB
#undef PG8_MMA
#undef PG8_WAIT_V
#undef PG8_WAIT_L
#undef PG8_BAR
#undef PG8_SCHED
}
}

constexpr size_t SHM_V = 64 * 128 * 2;
#define SBAR() __builtin_amdgcn_sched_barrier(0)
__device__ __forceinline__ int crow(int r, int hi) { return (r & 3) + 8 * (r >> 2) + 4 * hi; }
__device__ __forceinline__ void partialSM(f32x16& p0, f32x16& p1, float& m_reg, float& mn, float& alpha, float C, float thrs) {
  float pmax = p0[0];
#pragma unroll
  for (int r = 1; r < 16; ++r) pmax = fmaxf(pmax, p0[r]);
#pragma unroll
  for (int r = 0; r < 16; ++r) pmax = fmaxf(pmax, p1[r]);
  { auto rr = __builtin_amdgcn_permlane32_swap(__float_as_uint(pmax), __float_as_uint(pmax), false, false);
    pmax = fmaxf(__uint_as_float(rr[0]), __uint_as_float(rr[1])); }
  if (__builtin_expect(__all(pmax - m_reg <= thrs), 1)) { mn = m_reg; alpha = 1.f; }
  else { mn = fmaxf(m_reg, pmax); alpha = __builtin_amdgcn_exp2f((m_reg - mn) * C); m_reg = mn; }
  float mnC = -mn * C;
#pragma unroll
  for (int r = 0; r < 16; ++r) p0[r] = fmaf(p0[r], C, mnC);
#pragma unroll
  for (int r = 0; r < 16; ++r) p1[r] = fmaf(p1[r], C, mnC);
#pragma unroll
  for (int r = 0; r < 16; ++r) p0[r] = __builtin_amdgcn_exp2f(p0[r]);
}
__device__ __forceinline__ void finishSM(f32x16& p0, f32x16& p1, float alpha, float& l_reg, bf16x8& pa0, bf16x8& pa1, bf16x8& pa2, bf16x8& pa3) {
#pragma unroll
  for (int r = 0; r < 16; ++r) p1[r] = __builtin_amdgcn_exp2f(p1[r]);
  float ps = 0;
#pragma unroll
  for (int r = 0; r < 16; ++r) ps += p0[r];
#pragma unroll
  for (int r = 0; r < 16; ++r) ps += p1[r];
  { auto rr = __builtin_amdgcn_permlane32_swap(__float_as_uint(ps), __float_as_uint(ps), false, false);
    ps = __uint_as_float(rr[0]) + __uint_as_float(rr[1]); }
  l_reg = l_reg * alpha + ps;
#define PK4(P, BASE, OUT) do { unsigned a0 = cvtpk(P[BASE + 0], P[BASE + 1]), a1 = cvtpk(P[BASE + 2], P[BASE + 3]);   \
    unsigned b0 = cvtpk(P[BASE + 4], P[BASE + 5]), b1 = cvtpk(P[BASE + 6], P[BASE + 7]);                              \
    auto r0 = __builtin_amdgcn_permlane32_swap(a0, b0, false, false); auto r1 = __builtin_amdgcn_permlane32_swap(a1, b1, false, false); \
    u32x4 w = {r0[0], r1[0], r0[1], r1[1]}; OUT = *reinterpret_cast<bf16x8*>(&w); } while (0)
  PK4(p0, 0, pa0); PK4(p0, 8, pa1); PK4(p1, 0, pa2); PK4(p1, 8, pa3);
#undef PK4
}
template <int DQK> __device__ __forceinline__ int kswz(int row, int colB) { return row * (DQK * 2) + (colB ^ ((row & 7) << 4)); }
template <int DQK>
__device__ __forceinline__ void qkt(f32x16& p0, f32x16& p1, const char* Ks, const bf16x8* qr, int r32, int hi) {
  p0 = f32x16{}; p1 = f32x16{};
#pragma unroll
  for (int d0 = 0; d0 < DQK / 16; ++d0) { int cb = (d0 * 16 + hi * 8) * 2;
    bf16x8 b0 = *reinterpret_cast<const bf16x8*>(Ks + kswz<DQK>(r32, cb));
    bf16x8 b1 = *reinterpret_cast<const bf16x8*>(Ks + kswz<DQK>(32 + r32, cb));
    p0 = __builtin_amdgcn_mfma_f32_32x32x16_bf16(b0, qr[d0], p0, 0, 0, 0);
    p1 = __builtin_amdgcn_mfma_f32_32x32x16_bf16(b1, qr[d0], p1, 0, 0, 0); }
}
__device__ __forceinline__ int v_st(int k, int c) { const int kk = (k & ~0xC) | ((k & 4) << 1) | ((k & 8) >> 1); return ((kk >> 3) * 4 + (c >> 5)) * 512 + ((kk & 7) * 32 + (c & 31)) * 2; }
__device__ __forceinline__ int v_rd_base(int lane) { return ((lane & 3) << 3) | (((lane >> 2) & 3) << 6) | (((lane >> 4) & 1) << 5) | (((lane >> 5) & 1) << 8); }
constexpr int v_rd_off(int d0, int ks, int half) { return d0 * 512 + ks * 4096 + half * 2048; }
template <int OFF> __device__ __forceinline__ s16x4 tr_read(int vb) {
  s16x4 r; asm volatile("ds_read_b64_tr_b16 %0, %1 offset:%2" : "=&v"(r) : "v"(vb), "i"(OFF) : "memory"); return r;
}
template <int D0> __device__ __forceinline__ void pv_one(f32x16& od, int vb, bf16x8 pa0, bf16x8 pa1, bf16x8 pa2, bf16x8 pa3) {
  const s16x4 l0 = tr_read<v_rd_off(D0, 0, 0)>(vb), h0 = tr_read<v_rd_off(D0, 0, 1)>(vb), l1 = tr_read<v_rd_off(D0, 1, 0)>(vb), h1 = tr_read<v_rd_off(D0, 1, 1)>(vb);
  const s16x4 l2 = tr_read<v_rd_off(D0, 2, 0)>(vb), h2 = tr_read<v_rd_off(D0, 2, 1)>(vb), l3 = tr_read<v_rd_off(D0, 3, 0)>(vb), h3 = tr_read<v_rd_off(D0, 3, 1)>(vb);
  asm volatile("s_waitcnt lgkmcnt(0)" ::: "memory"); SBAR();
#define PK(L, H) (bf16x8){L[0], L[1], L[2], L[3], H[0], H[1], H[2], H[3]}
  od = __builtin_amdgcn_mfma_f32_32x32x16_bf16(pa0, PK(l0, h0), od, 0, 0, 0);
  od = __builtin_amdgcn_mfma_f32_32x32x16_bf16(pa1, PK(l1, h1), od, 0, 0, 0);
  od = __builtin_amdgcn_mfma_f32_32x32x16_bf16(pa2, PK(l2, h2), od, 0, 0, 0);
  od = __builtin_amdgcn_mfma_f32_32x32x16_bf16(pa3, PK(l3, h3), od, 0, 0, 0);
#undef PK
}
__device__ __forceinline__ void pv_d0(f32x16* o, int vb, bf16x8 pa0, bf16x8 pa1, bf16x8 pa2, bf16x8 pa3) {
  pv_one<0>(o[0], vb, pa0, pa1, pa2, pa3); pv_one<1>(o[1], vb, pa0, pa1, pa2, pa3); pv_one<2>(o[2], vb, pa0, pa1, pa2, pa3); pv_one<3>(o[3], vb, pa0, pa1, pa2, pa3);
}

struct AttnArgs {
  const bf16_t* Q; int ldq;
  const bf16_t* K; int ldk;
  const bf16_t* K2; int ldk2;
  const bf16_t* V; int ldv;
  int crow0, lrow0, NT;
  float C, thrs;
  bf16_t* O; int ldo;
  float* tmp;
  float lam, postmul; const float* subln;
  float sinkl2;
  int q0, kstart;
  const float* rc; const float* rs; int tq0;
  const float* qgain;
};
template <int DQK, int MODE, int SDEPTH, int QT>
__device__ __forceinline__ void attn_unit(const AttnArgs& a, char* lds) {
  constexpr int SHM_K = 64 * DQK * 2;
  constexpr int NLD = (DQK == 64 ? 3 : (DQK == 128 ? 4 : 5));
  int tid = threadIdx.x; asm volatile("" : "+v"(tid));
  const int wid = tid >> 6, lane = tid & 63, r32 = lane & 31, hi = lane >> 5;
  char* V_lds = lds; char* K_lds = lds + 2 * SHM_V;
  float* wsl = (float*)(lds + 2 * SHM_V + 2 * SHM_K) + wid * 64; float* li_l = wsl; float* al_l = wsl + 32;
  float m_reg = -1e30f, l_reg = 0; f32x16 o[4] = {}; bf16x8 qr[DQK / 16];
  const float C = a.C, thrs = a.thrs;
  const bf16_t* Qw = a.Q + (size_t)(wid * 32 + r32) * a.ldq + hi * 8;
#pragma unroll
  for (int d0 = 0; d0 < DQK / 16; ++d0) qr[d0] = *reinterpret_cast<const bf16x8*>(Qw + d0 * 16);
  if constexpr (QT == 1) {
    float ss = 0.f;
#pragma unroll
    for (int d0 = 0; d0 < 8; ++d0) { const u32x4 w = *reinterpret_cast<u32x4*>(&qr[d0]);
#pragma unroll
      for (int e = 0; e < 4; ++e) { const float lo = bflo(w[e]), hh = bfhi(w[e]); ss += lo * lo + hh * hh; } }
    ss += shflx(ss, 32, lane);
    const float rstd = rsqrtf(ss * (1.0f / 128.0f) + EPS);
#pragma unroll
    for (int d0 = 0; d0 < 8; ++d0) { const float* gp = a.qgain + d0 * 16 + hi * 8; const f32x4 g0 = *(const f32x4*)gp, g1 = *(const f32x4*)(gp + 4);
      const u32x4 w = *reinterpret_cast<u32x4*>(&qr[d0]); u32x4 y;
      y.x = cvtpk(bflo(w.x) * rstd * g0[0], bfhi(w.x) * rstd * g0[1]); y.y = cvtpk(bflo(w.y) * rstd * g0[2], bfhi(w.y) * rstd * g0[3]);
      y.z = cvtpk(bflo(w.z) * rstd * g1[0], bfhi(w.z) * rstd * g1[1]); y.w = cvtpk(bflo(w.w) * rstd * g1[2], bfhi(w.w) * rstd * g1[3]);
      qr[d0] = *reinterpret_cast<bf16x8*>(&y); }
  }
  if constexpr (QT != 0) {
    if (a.tq0 >= 0) {
      constexpr int RB = (DQK == 192) ? 8 : 0, RH = (DQK == 128) ? 64 : 32;
      const int t = a.tq0 + wid * 32 + r32;
#pragma unroll
      for (int g = 0; g < RH / 16; ++g) {
        const float* cp = a.rc + (size_t)t * RH + g * 16 + hi * 8; const float* sp = a.rs + (size_t)t * RH + g * 16 + hi * 8;
        const f32x4 c0 = *(const f32x4*)cp, c1 = *(const f32x4*)(cp + 4), s0 = *(const f32x4*)sp, s1 = *(const f32x4*)(sp + 4);
        const u32x4 xa = *reinterpret_cast<u32x4*>(&qr[RB + g]), xb = *reinterpret_cast<u32x4*>(&qr[RB + g + RH / 16]);
        u32x4 ya, yb;
#pragma unroll
        for (int w = 0; w < 4; ++w) {
          const float cl = w < 2 ? c0[2 * w] : c1[2 * w - 4], ch = w < 2 ? c0[2 * w + 1] : c1[2 * w - 3];
          const float sl = w < 2 ? s0[2 * w] : s1[2 * w - 4], sh = w < 2 ? s0[2 * w + 1] : s1[2 * w - 3];
          const float x1l = bflo(xa[w]), x1h = bfhi(xa[w]), x2l = bflo(xb[w]), x2h = bfhi(xb[w]);
          ya[w] = cvtpk(x1l * cl - x2l * sl, x1h * ch - x2h * sh);
          yb[w] = cvtpk(x2l * cl + x1l * sl, x2h * ch + x1h * sh);
        }
        qr[RB + g] = *reinterpret_cast<bf16x8*>(&ya); qr[RB + g + RH / 16] = *reinterpret_cast<bf16x8*>(&yb);
      }
    }
  }
  const int sr = tid >> 4, sc = (tid & 15) * 8, vst0 = v_st(sr, sc), vst1 = v_st(32 + sr, sc);
  const int kr = tid >> 3, kc = (tid & 7) * 8;
  const int vb0 = (int)(uintptr_t)V_lds + v_rd_base(lane);
  struct { bf16x8 vs0, vs1, ks0, ks1, ks2; } sr_[SDEPTH];
#define KROW(j) ((j) < 4 ? a.crow0 + (j) * 64 : a.lrow0 + ((j) - 4) * 64)
  const unsigned voV = (unsigned)(sr * a.ldv + sc) * 2u, voK = (DQK == 64) ? (unsigned)(kr * a.ldk + kc) * 2u : (unsigned)(sr * a.ldk + sc) * 2u, voK2 = (DQK == 192) ? (unsigned)(kr * a.ldk2 + kc) * 2u : 0u;
#define SLOAD(i, j) do { const int rb_ = __builtin_amdgcn_readfirstlane(KROW(j)); \
    const char* vb_ = (const char*)a.V + (size_t)rb_ * a.ldv * 2; const char* kb_ = (const char*)a.K + (size_t)rb_ * a.ldk * 2; \
    sr_[i].vs0 = *(const bf16x8*)(vb_ + voV); sr_[i].vs1 = *(const bf16x8*)(vb_ + (size_t)a.ldv * 64 + voV); \
    if constexpr (DQK == 64) { sr_[i].ks0 = *(const bf16x8*)(kb_ + voK); } \
    else { sr_[i].ks0 = *(const bf16x8*)(kb_ + voK); sr_[i].ks1 = *(const bf16x8*)(kb_ + (size_t)a.ldk * 64 + voK); } \
    if constexpr (DQK == 192) { sr_[i].ks2 = *(const bf16x8*)((const char*)a.K2 + (size_t)rb_ * a.ldk2 * 2 + voK2); } } while (0)
#define SWRITE(b, i) do { *(bf16x8*)(V_lds + (b) * SHM_V + vst0) = sr_[i].vs0; *(bf16x8*)(V_lds + (b) * SHM_V + vst1) = sr_[i].vs1; \
    if constexpr (DQK == 64) { *(bf16x8*)(K_lds + (b) * SHM_K + kswz<DQK>(kr, kc * 2)) = sr_[i].ks0; } \
    else { *(bf16x8*)(K_lds + (b) * SHM_K + kswz<DQK>(sr, sc * 2)) = sr_[i].ks0; *(bf16x8*)(K_lds + (b) * SHM_K + kswz<DQK>(32 + sr, sc * 2)) = sr_[i].ks1; } \
    if constexpr (DQK == 192) { *(bf16x8*)(K_lds + (b) * SHM_K + kswz<DQK>(kr, (128 + kc) * 2)) = sr_[i].ks2; } } while (0)
#define SWAIT() do { if constexpr (SDEPTH == 2) asm volatile("s_waitcnt vmcnt(%0)" :: "n"(NLD) : "memory"); else asm volatile("s_waitcnt vmcnt(0)" ::: "memory"); } while (0)
#define RESC(al) do { if (__any((al) < 1.f)) { if (hi == 0) al_l[r32] = (al); asm volatile("s_waitcnt lgkmcnt(0)" ::: "memory"); \
    _Pragma("unroll") for (int d = 0; d < 4; ++d) _Pragma("unroll") for (int r = 0; r < 16; ++r) o[d][r] *= al_l[crow(r, hi)]; } } while (0)
#define MASK(P0, P1, j) do { if constexpr (MODE == 3) { if ((j) >= 4) { const int dq_ = a.kstart + ((j) - 4) * 64 - (a.q0 + wid * 32 + r32); \
    _Pragma("unroll") for (int r = 0; r < 16; ++r) { const int d0_ = dq_ + crow(r, hi), d1_ = d0_ + 32; \
      if (d0_ > 128 || d0_ < -128) P0[r] = -1e30f; if (d1_ > 128 || d1_ < -128) P1[r] = -1e30f; } } } } while (0)
  f32x16 pA0, pA1, pB0, pB1; float mnA, mnB, alA, alB; bf16x8 pa0, pa1, pa2, pa3; const int NT = a.NT;
  constexpr int SE = 0, SO = SDEPTH - 1;
  SLOAD(SE, 0); asm volatile("s_waitcnt vmcnt(0)" ::: "memory"); SWRITE(0, SE); __syncthreads();
  qkt<DQK>(pA0, pA1, K_lds, qr, r32, hi); MASK(pA0, pA1, 0); partialSM(pA0, pA1, m_reg, mnA, alA, C, thrs);
  SLOAD(SO, 1); if constexpr (SDEPTH == 2) { if (2 < NT) SLOAD(SE, 2); }
  SWAIT(); SWRITE(1, SO); __syncthreads();
  for (int j = 1; j + 1 < NT; j += 2) {
    SBAR(); qkt<DQK>(pB0, pB1, K_lds + SHM_K, qr, r32, hi); MASK(pB0, pB1, j);
    finishSM(pA0, pA1, alA, l_reg, pa0, pa1, pa2, pa3); SBAR();
    if constexpr (SDEPTH == 2) { SLOAD(SO, j + 2); } else { SLOAD(SE, j + 1); } SBAR();
    pv_d0(o, vb0, pa0, pa1, pa2, pa3); partialSM(pB0, pB1, m_reg, mnB, alB, C, thrs);
    __syncthreads(); SWAIT(); SWRITE(0, SE);
    RESC(alB); __syncthreads();
    SBAR(); qkt<DQK>(pA0, pA1, K_lds, qr, r32, hi); MASK(pA0, pA1, j + 1);
    finishSM(pB0, pB1, alB, l_reg, pa0, pa1, pa2, pa3); SBAR();
    if constexpr (SDEPTH == 2) { if (j + 3 < NT) SLOAD(SE, j + 3); } else { SLOAD(SO, j + 2); } SBAR();
    pv_d0(o, vb0 + (int)SHM_V, pa0, pa1, pa2, pa3); partialSM(pA0, pA1, m_reg, mnA, alA, C, thrs);
    __syncthreads(); SWAIT(); SWRITE(1, SO);
    RESC(alA); __syncthreads();
  }
  SBAR(); qkt<DQK>(pB0, pB1, K_lds + SHM_K, qr, r32, hi); MASK(pB0, pB1, NT - 1);
  finishSM(pA0, pA1, alA, l_reg, pa0, pa1, pa2, pa3); SBAR();
  pv_d0(o, vb0, pa0, pa1, pa2, pa3); partialSM(pB0, pB1, m_reg, mnB, alB, C, thrs);
  __syncthreads(); RESC(alB);
  finishSM(pB0, pB1, alB, l_reg, pa0, pa1, pa2, pa3); SBAR();
  pv_d0(o, vb0 + (int)SHM_V, pa0, pa1, pa2, pa3);
  if constexpr (MODE == 3) l_reg += __builtin_amdgcn_exp2f(a.sinkl2 - m_reg * C);
  if (hi == 0) li_l[r32] = l_reg; asm volatile("s_waitcnt lgkmcnt(0)" ::: "memory");
  float rli[16];
#pragma unroll
  for (int r = 0; r < 16; ++r) rli[r] = __builtin_amdgcn_rcpf(li_l[crow(r, hi)]);
  char* R = lds + 61440 + wid * 8704;
  if constexpr (MODE == 0 || MODE == 3) __syncthreads();
  if constexpr (MODE == 2) {
    float g[4];
#pragma unroll
    for (int d0 = 0; d0 < 4; ++d0) g[d0] = a.subln[d0 * 32 + r32] * a.postmul;
#pragma unroll
    for (int r = 0; r < 16; ++r) { char* Rr = R + crow(r, hi) * 272 + r32 * 2;
      float v[4], ss = 0.f;
#pragma unroll
      for (int d0 = 0; d0 < 4; ++d0) { const float o1 = __uint_as_float((unsigned)(*(const unsigned short*)(Rr + d0 * 64)) << 16); v[d0] = o1 - a.lam * (o[d0][r] * rli[r]); ss += v[d0] * v[d0]; }
      ss = half_sum32(ss, lane);
      const float rstd = rsqrtf(ss * (1.0f / 128.0f) + EPS);
#pragma unroll
      for (int d0 = 0; d0 < 4; ++d0) *(unsigned short*)(Rr + d0 * 64) = (unsigned short)(cvtpk(v[d0] * rstd * g[d0], 0.f) & 0xffffu); }
  } else {
#pragma unroll
    for (int r = 0; r < 16; ++r) { char* Rr = R + crow(r, hi) * 272 + r32 * 2;
#pragma unroll
      for (int d0 = 0; d0 < 4; ++d0) *(unsigned short*)(Rr + d0 * 64) = (unsigned short)(cvtpk(o[d0][r] * rli[r], 0.f) & 0xffffu); }
  }
  if constexpr (MODE != 1) {
    asm volatile("s_waitcnt lgkmcnt(0)" ::: "memory");
    bf16_t* Ow = a.O + (size_t)(wid * 32) * a.ldo;
#pragma unroll
    for (int i = 0; i < 8; ++i) { const int c = i * 64 + lane, row = c >> 4, cc = c & 15;
      const u32x4 w = *(const u32x4*)(R + row * 272 + cc * 16);
      *(u32x4*)(Ow + (size_t)row * a.ldo + cc * 8) = w; }
  }
  __syncthreads();
#undef KROW
#undef SLOAD
#undef SWRITE
#undef SWAIT
#undef RESC
#undef MASK
}

struct TJob { const float* src; const float* src2; bf16_t* dst; int K, Nsrc, Nd, mode; };
__device__ __forceinline__ TJob tjob(const Params& p, int l, int m) {
  char* W = p.ws + WS_W + (size_t)l * SZ_WL; TJob j; j.src2 = nullptr; j.mode = 0;
  switch (m) {
    case 0: j.src = p.in[10] + (size_t)l * DM * INC; j.dst = (bf16_t*)(W + OFF_WIN); j.K = DM; j.Nsrc = INC; j.Nd = LDP; break;
    case 1: j.src = p.in[20] + (size_t)l * 512 * 768; j.dst = (bf16_t*)(W + OFF_WUQ); j.K = 512; j.Nsrc = 768; j.Nd = 768; break;
    case 2: j.src = p.in[22] + (size_t)l * 256 * 1024; j.dst = (bf16_t*)(W + OFF_WUKV); j.K = 256; j.Nsrc = 1024; j.Nd = 1024; break;
    case 3: j.src = p.in[23] + (size_t)l * DM * DM; j.dst = (bf16_t*)(W + OFF_WOUT); j.K = DM; j.Nsrc = DM; j.Nd = DM; break;
    case 4: j.src = p.in[24] + (size_t)l * DM * DFF; j.src2 = p.in[25] + (size_t)l * DM * DFF; j.dst = (bf16_t*)(W + OFF_WGU); j.K = DM; j.Nsrc = DFF; j.Nd = 2 * DFF; j.mode = 1; break;
    default: j.src = p.in[26] + (size_t)l * DFF * DM; j.dst = (bf16_t*)(W + OFF_WDN); j.K = DFF; j.Nsrc = DM; j.Nd = DM; break;
  }
  return j;
}
__device__ __forceinline__ void ttile(const TJob& j, int tn, int tk, float* tl) {
  const int tid = otid(), k = tid >> 3, n8 = (tid & 7) * 8, n0 = tn * 64, k0 = tk * 256;
  const float* s = j.src; int scol = n0;
  if (j.mode == 1) { const int pn = n0 >> 8, r = n0 & 255; s = (r < 128) ? j.src : j.src2; scol = pn * 128 + (r & 127); }
  f32x4 va[4], vb[4];
  const bool nz = (j.mode == 1 || n0 < j.Nsrc);
#pragma unroll
  for (int kk = 0; kk < 4; ++kk) { va[kk] = (f32x4){0.f, 0.f, 0.f, 0.f}; vb[kk] = va[kk];
    if (nz) { const float* q = s + (size_t)(k0 + kk * 64 + k) * j.Nsrc + scol + n8; va[kk] = *(const f32x4*)q; vb[kk] = *(const f32x4*)(q + 4); } }
  __syncthreads();
#pragma unroll
  for (int kk = 0; kk < 4; ++kk)
#pragma unroll
    for (int i = 0; i < 4; ++i) { tl[(kk * 64 + k) * 65 + n8 + i] = va[kk][i]; tl[(kk * 64 + k) * 65 + n8 + 4 + i] = vb[kk][i]; }
  __syncthreads();
  const int n = tid >> 3, k8 = (tid & 7) * 8;
#pragma unroll
  for (int kk = 0; kk < 4; ++kk) {
    float v[8];
#pragma unroll
    for (int i = 0; i < 8; ++i) v[i] = tl[(kk * 64 + k8 + i) * 65 + n];
    u32x4 w = {cvtpk(v[0], v[1]), cvtpk(v[2], v[3]), cvtpk(v[4], v[5]), cvtpk(v[6], v[7])};
    *(u32x4*)(j.dst + (size_t)(n0 + n) * j.K + k0 + kk * 64 + k8) = w;
  }
}
__device__ __forceinline__ void phase0(const Params& p, char* lds) {
  const int tid = otid(), G = gridDim.x, bid = obid();
  float* tl = (float*)lds;
  int base = 0;
  for (int l = 0; l < 2; ++l)
    for (int m = 0; m < 6; ++m) {
      const TJob j = tjob(p, l, m); const int ntn = j.Nd / 64, ntk = j.K / 256, total = ntn * ntk;
      int first = (bid - (base % G) + G) % G;
      for (int t = first; t < total; t += G) ttile(j, t / ntk, t % ntk, tl);
      base += total;
    }
  __syncthreads();
  float* sv = (float*)lds;
  float* red = sv + 9 * DM;
  for (int i = tid; i < 9 * DM; i += 512) { const int r = i / DM, k = i % DM; const float c = (r < 8) ? p.in[1][r * DM + k] : p.in[3][k]; sv[i] = c / (1.0f + expf(-c)); }
  __syncthreads();
  float* mod = (float*)(p.ws + WS_MOD);
  for (int u = bid; u < 2 * 384; u += G) {
    const int l = u / 384, n0 = (u % 384) * 32, cl = tid & 7, sl = tid >> 3;
    const float* w = p.in[4] + (size_t)l * DM * 12288 + n0 + 4 * cl;
    f32x4 acc[9];
#pragma unroll
    for (int r = 0; r < 9; ++r) acc[r] = (f32x4){0.f, 0.f, 0.f, 0.f};
#pragma unroll 8
    for (int k = sl * 32; k < sl * 32 + 32; ++k) { const f32x4 wv = *(const f32x4*)(w + (size_t)k * 12288);
#pragma unroll
      for (int r = 0; r < 9; ++r) acc[r] += wv * sv[r * DM + k]; }
    const int lane = tid & 63;
#pragma unroll
    for (int r = 0; r < 9; ++r)
#pragma unroll
      for (int e = 0; e < 4; ++e) { float v = acc[r][e]; v += shflx(v, 8, lane); v += shflx(v, 16, lane); v += shflx(v, 32, lane); acc[r][e] = v; }
    if (lane < 8) {
#pragma unroll
      for (int r = 0; r < 9; ++r) *(f32x4*)(red + ((tid >> 6) * 9 + r) * 32 + 4 * lane) = acc[r];
    }
    __syncthreads();
    if (tid < 288) { const int r = tid >> 5, c2 = tid & 31; float t = 0.f;
#pragma unroll
      for (int s2 = 0; s2 < 8; ++s2) t += red[(s2 * 9 + r) * 32 + c2];
      mod[((size_t)l * 9 + r) * 12288 + n0 + c2] = t + p.in[5][(size_t)l * 12288 + n0 + c2]; }
    __syncthreads();
  }
  float* c128 = (float*)(p.ws + WS_ROPE); float* s128 = c128 + 4096 * 64; float* c64 = s128 + 4096 * 64; float* s64 = c64 + 4096 * 32;
  for (int i = bid * 512 + tid; i < 4096 * 64; i += G * 512) { const int t = i >> 6, a = i & 63; const float pos = (a < 32) ? (float)(t >> 6) : (float)(t & 63);
    const float inv = exp2f(-(float)(a & 31) * (13.287712379549449f / 32.0f)); const float ang = pos * inv; c128[i] = cosf(ang); s128[i] = sinf(ang); }
  for (int i = bid * 512 + tid; i < 4096 * 32; i += G * 512) { const int t = i >> 5, a = i & 31; const float pos = (a < 16) ? (float)(t >> 6) : (float)(t & 63);
    const float inv = exp2f(-(float)(a & 15) * (13.287712379549449f / 16.0f)); const float ang = pos * inv; c64[i] = cosf(ang); s64[i] = sinf(ang); }
  if (bid == 0 && tid < 128) {
    const int l = tid >> 6, i = tid & 63;
    float a1 = p.in[13][l * 64 + i] * p.in[14][l * 64 + i], a2 = p.in[15][l * 64 + i] * p.in[16][l * 64 + i];
    a1 = wave_sum64(a1, tid & 63); a2 = wave_sum64(a2, tid & 63);
    if (i == 0) ((float*)(p.ws + WS_MISC))[l] = expf(a1) - expf(a2) + p.lam_init[l];
  }
}

struct RowArgs {
  const float* xlat_in; const float* xctx_in; float* xlat_out; float* xctx_out;
  const bf16_t* xlat_in16; bf16_t* xlat_out16;
  const bf16_t* Y; const float* gpost; const float* gate;
  bf16_t* H; const float* gnext; const float* shift; const float* scale;
  int M;
  int r0, vb, vG;
};
__device__ __forceinline__ void row_phase(const RowArgs& a) {
  const int tid_ = otid(), lane = tid_ & 63, gw = a.r0 + a.vb * 8 + (tid_ >> 6), nw = a.vG * 8;
  f32x4 x[8], xn[8]; u32x2 yw[8], ywn[8], xw[8], xwn[8];
#define ROW_LOAD(X, XW, YW, r_) do { const bool lat_ = (r_) < NLAT; const float* xin_ = lat_ ? a.xlat_in + (size_t)(r_) * DM : a.xctx_in + (size_t)((r_) - NLAT) * DM; \
    if (lat_ && a.xlat_in16) { _Pragma("unroll") for (int i = 0; i < 8; ++i) XW[i] = __builtin_nontemporal_load((const u32x2*)(a.xlat_in16 + (size_t)(r_) * DM + (i * 64 + lane) * 4)); } \
    else { _Pragma("unroll") for (int i = 0; i < 8; ++i) X[i] = __builtin_nontemporal_load((const f32x4*)(xin_ + (i * 64 + lane) * 4)); } \
    if (a.Y) { _Pragma("unroll") for (int i = 0; i < 8; ++i) YW[i] = __builtin_nontemporal_load((const u32x2*)(a.Y + (size_t)(r_) * DM + (i * 64 + lane) * 4)); } } while (0)
  if (gw < a.M) ROW_LOAD(x, xw, yw, gw);
  for (int row = gw; row < a.M; row += nw) {
    const bool lat = row < NLAT; const int bi = lat ? (row >> 12) : 8;
    float* xout = lat ? a.xlat_out + (size_t)row * DM : a.xctx_out + (size_t)(row - NLAT) * DM;
    const int rnext = row + nw;
    if (rnext < a.M) ROW_LOAD(xn, xwn, ywn, rnext);
    if (lat && a.xlat_in16) {
#pragma unroll
      for (int i = 0; i < 8; ++i) x[i] = (f32x4){bflo(xw[i].x), bfhi(xw[i].x), bflo(xw[i].y), bfhi(xw[i].y)};
    }
    if (a.Y) {
      f32x4 y[8]; float ss = 0.f;
#pragma unroll
      for (int i = 0; i < 8; ++i) { const u32x2 w = yw[i];
        y[i] = (f32x4){bflo(w.x), bfhi(w.x), bflo(w.y), bfhi(w.y)}; ss += y[i][0] * y[i][0] + y[i][1] * y[i][1] + y[i][2] * y[i][2] + y[i][3] * y[i][3]; }
      ss = wave_sum64(ss, lane); const float rstd = rsqrtf(ss * (1.0f / DM) + EPS);
      const float* gt = a.gate + (size_t)bi * 12288;
#pragma unroll
      for (int i = 0; i < 8; ++i) { const int c = (i * 64 + lane) * 4; const f32x4 gp = *(const f32x4*)(a.gpost + c), gg = *(const f32x4*)(gt + c);
        x[i] = x[i] + gg * (y[i] * rstd * gp);
        if (lat && a.xlat_out16) { u32x2 w; w.x = cvtpk(x[i][0], x[i][1]); w.y = cvtpk(x[i][2], x[i][3]); __builtin_nontemporal_store(w, (u32x2*)(a.xlat_out16 + (size_t)row * DM + c)); }
        else __builtin_nontemporal_store(x[i], (f32x4*)(xout + c)); }
    }
    if (a.H) {
      float ss = 0.f;
#pragma unroll
      for (int i = 0; i < 8; ++i) ss += x[i][0] * x[i][0] + x[i][1] * x[i][1] + x[i][2] * x[i][2] + x[i][3] * x[i][3];
      ss = wave_sum64(ss, lane); const float rstd = rsqrtf(ss * (1.0f / DM) + EPS);
      const float* sh = a.shift + (size_t)bi * 12288; const float* sc = a.scale + (size_t)bi * 12288;
#pragma unroll
      for (int i = 0; i < 8; ++i) { const int c = (i * 64 + lane) * 4; const f32x4 gn = *(const f32x4*)(a.gnext + c), s1 = *(const f32x4*)(sh + c), s2 = *(const f32x4*)(sc + c);
        const f32x4 h = (x[i] * rstd * gn) * (s2 + 1.0f) + s1;
        u32x2 w; w.x = cvtpk(h[0], h[1]); w.y = cvtpk(h[2], h[3]); __builtin_nontemporal_store(w, (u32x2*)(a.H + (size_t)row * DM + c)); }
    }
#pragma unroll
    for (int i = 0; i < 8; ++i) { x[i] = xn[i]; yw[i] = ywn[i]; xw[i] = xwn[i]; }
  }
#undef ROW_LOAD
}

__device__ __forceinline__ void unpack8(const u32x4 w, float (&f)[8]) { f[0] = bflo(w.x); f[1] = bfhi(w.x); f[2] = bflo(w.y); f[3] = bfhi(w.y); f[4] = bflo(w.z); f[5] = bfhi(w.z); f[6] = bflo(w.w); f[7] = bfhi(w.w); }
__device__ __forceinline__ u32x4 pack8(const float (&f)[8]) { u32x4 w; w.x = cvtpk(f[0], f[1]); w.y = cvtpk(f[2], f[3]); w.z = cvtpk(f[4], f[5]); w.w = cvtpk(f[6], f[7]); return w; }
__device__ __forceinline__ void ld8f(const float* p, float (&f)[8]) { const f32x4 a = *(const f32x4*)p, b = *(const f32x4*)(p + 4); f[0] = a[0]; f[1] = a[1]; f[2] = a[2]; f[3] = a[3]; f[4] = b[0]; f[5] = b[1]; f[6] = b[2]; f[7] = b[3]; }
struct PrepRow { u32x4 ha, hb, ga, gb, q, kv; };
__device__ __forceinline__ void prep_phase(const Params& p, int l) {
  char* wsb = wsp(p);
  bf16_t* P = (bf16_t*)(wsb + WS_P);
  const float* kg = p.in[12] + l * 128; const float* qn = p.in[19] + l * 512; const float* kvn = p.in[21] + l * 256;
  const float* c128 = (const float*)(wsb + WS_ROPE); const float* s128 = c128 + 4096 * 64; const float* c64 = s128 + 4096 * 64; const float* s64 = c64 + 4096 * 32;
  const int tid_ = otid(), lane = tid_ & 63, gw = obid() * 8 + (tid_ >> 6), nw = gridDim.x * 8;
  const int hidx = lane >> 3, hj = lane & 7, gj = lane & 3, l2 = lane & 31;
  const int hcol = (hidx < 2 ? C_GK + hidx * 128 : C_WK + ((hidx - 2) & 1) * 128) + 8 * hj;
  const int gcol = (lane < 32 ? C_DK + (lane >> 2) * 64 : C_MKR) + 8 * gj;
#define PREP_LOAD(D, r_) do { const bool lat_ = (r_) < NLAT; const bf16_t* pr_ = P + (size_t)(r_) * LDP; const u32x4 z_ = {0u, 0u, 0u, 0u}; \
    const bool hact_ = hidx < 4 && (lat_ || hidx < 2), gact_ = lat_ && lane < 36; \
    D.ha = z_; D.hb = z_; D.ga = z_; D.gb = z_; D.kv = z_; \
    if (hact_) { D.ha = *(const u32x4*)(pr_ + hcol); D.hb = *(const u32x4*)(pr_ + hcol + 64); } \
    if (gact_) { D.ga = *(const u32x4*)(pr_ + gcol); D.gb = *(const u32x4*)(pr_ + gcol + 32); } \
    D.q = *(const u32x4*)(pr_ + C_MQ + 8 * lane); if (lane < 32) D.kv = *(const u32x4*)(pr_ + C_MKV + 8 * l2); } while (0)
  PrepRow cur, nxt;
  if (gw < NROWS) PREP_LOAD(cur, gw);
  for (int row = gw; row < NROWS; row += nw) {
    const bool lat = row < NLAT; const int t = row & 4095;
    bf16_t* pr = P + (size_t)row * LDP;
    const bool hact = hidx < 4 && (lat || hidx < 2), gact = lat && lane < 36;
    if (row + nw < NROWS) PREP_LOAD(nxt, row + nw);
    { float xa[8], xb[8]; unpack8(cur.ha, xa); unpack8(cur.hb, xb);
      float ss = 0.f;
#pragma unroll
      for (int e = 0; e < 8; ++e) ss += xa[e] * xa[e] + xb[e] * xb[e];
      ss += shflx(ss, 1, lane); ss += shflx(ss, 2, lane); ss += shflx(ss, 4, lane);
      if (hidx < 2) {
        const float rstd = rsqrtf(ss * (1.0f / 128.0f) + EPS);
        float ga[8], gb[8]; ld8f(kg + 8 * hj, ga); ld8f(kg + 64 + 8 * hj, gb);
#pragma unroll
        for (int e = 0; e < 8; ++e) { xa[e] *= rstd * ga[e]; xb[e] *= rstd * gb[e]; }
      }
      if (lat) {
        float c[8], sn[8]; ld8f(c128 + t * 64 + 8 * hj, c); ld8f(s128 + t * 64 + 8 * hj, sn);
#pragma unroll
        for (int e = 0; e < 8; ++e) { const float a0 = xa[e] * c[e] - xb[e] * sn[e], b0 = xb[e] * c[e] + xa[e] * sn[e]; xa[e] = a0; xb[e] = b0; }
      }
      if (hact) { *(u32x4*)(pr + hcol) = pack8(xa); *(u32x4*)(pr + hcol + 64) = pack8(xb); }
    }
    if (gact) {
      float c[8], sn[8]; ld8f(c64 + t * 32 + 8 * gj, c); ld8f(s64 + t * 32 + 8 * gj, sn);
      float xa[8], xb[8]; unpack8(cur.ga, xa); unpack8(cur.gb, xb);
#pragma unroll
      for (int e = 0; e < 8; ++e) { const float a0 = xa[e] * c[e] - xb[e] * sn[e], b0 = xb[e] * c[e] + xa[e] * sn[e]; xa[e] = a0; xb[e] = b0; }
      *(u32x4*)(pr + gcol) = pack8(xa); *(u32x4*)(pr + gcol + 32) = pack8(xb);
    }
    { float x[8]; unpack8(cur.q, x);
      float ss = 0.f;
#pragma unroll
      for (int e = 0; e < 8; ++e) ss += x[e] * x[e];
      ss = wave_sum64(ss, lane); const float rstd = rsqrtf(ss * (1.0f / 512.0f) + EPS);
      float g[8]; ld8f(qn + 8 * lane, g);
#pragma unroll
      for (int e = 0; e < 8; ++e) x[e] *= rstd * g[e];
      *(u32x4*)(pr + C_MQ + 8 * lane) = pack8(x);
      unpack8(cur.kv, x); float s2 = 0.f;
#pragma unroll
      for (int e = 0; e < 8; ++e) s2 += x[e] * x[e];
      s2 = wave_sum64(s2, lane); const float rstd2 = rsqrtf(s2 * (1.0f / 256.0f) + EPS);
      ld8f(kvn + 8 * l2, g);
#pragma unroll
      for (int e = 0; e < 8; ++e) x[e] *= rstd2 * g[e];
      if (lane < 32) *(u32x4*)(pr + C_MKV + 8 * l2) = pack8(x);
    }
    cur = nxt;
  }
#undef PREP_LOAD
}

__device__ __forceinline__ void attn_phase(const Params& p, int l, bool ctx_out, char* lds) {
  char* wsb = wsp(p);
  const bf16_t* P = (const bf16_t*)(wsb + WS_P); const bf16_t* QM = (const bf16_t*)(wsb + WS_QM); const bf16_t* KVM = (const bf16_t*)(wsb + WS_KVM);
  bf16_t* ATT = (bf16_t*)(wsb + WS_ATT);
  const float* c128 = (const float*)(wsb + WS_ROPE); const float* s128 = c128 + 4096 * 64;
  const float* c64 = (const float*)(wsb + WS_ROPE) + 2 * 4096 * 64; const float* s64 = c64 + 4096 * 32;
  const float lam = ((const float*)(wsb + WS_MISC))[l];
  const float L2E = 1.4426950408889634f;
  const int bid_ = obid();
  for (int v = bid_; v < 256; v += gridDim.x) {
    const int b = v & 7, j = v >> 3, hsel = j >> 4, qb = j & 15;
    const int nun = 8 + ((ctx_out && j < 16) ? 1 : 0);
    for (int u = 0; u < nun; ++u) {
      int type, head, qrow0, NT; bool isctx = (u == 8);
      if (!isctx) { type = u >> 1; head = (u & 1) * 2 + hsel; qrow0 = b * SEQ + qb * 256; NT = 68; }
      else { type = j >> 2; head = j & 3; qrow0 = NLAT + b * CTXL; NT = 4; }
      AttnArgs a;
      a.crow0 = NLAT + b * CTXL; a.lrow0 = b * SEQ; a.NT = NT; a.ldo = DM; a.tmp = (float*)(wsb + WS_TMP) + (size_t)bid_ * 256 * 128;
      a.lam = lam; a.postmul = p.one_minus_lam_init[l]; a.subln = p.in[17] + l * 128; a.sinkl2 = 0.f; a.q0 = 0; a.kstart = 0; a.rc = c64; a.rs = s64; a.tq0 = isctx ? -1 : qb * 256; a.qgain = p.in[11] + l * 128;
      a.K2 = nullptr; a.ldk2 = 0;
      if (type == 0) {
        const int g = head >> 1; const float sc = 0.08838834764831845f;
        a.Q = P + (size_t)qrow0 * LDP + C_GQ + head * 128; a.ldq = LDP; a.K = P + C_GK + g * 128; a.ldk = LDP; a.V = P + C_GV + g * 128; a.ldv = LDP;
        a.C = sc * L2E; a.thrs = 8.f / sc; a.O = ATT + (size_t)qrow0 * DM + head * 128; a.rc = c128; a.rs = s128;
        attn_unit<128, 0, 2, 1>(a, lds);
      } else if (type == 1) {
        const float sc = 0.125f;
        a.Q = P + (size_t)qrow0 * LDP + C_DQ + head * 128; a.ldq = LDP; a.K = P + C_DK + head * 128; a.ldk = LDP; a.V = P + C_DV + head * 128; a.ldv = LDP;
        a.C = sc * L2E; a.thrs = 8.f / sc; a.O = ATT + (size_t)qrow0 * DM + 512 + head * 128;
        attn_unit<64, 1, 2, 2>(a, lds);
        a.Q += 64; a.K += 64;
        attn_unit<64, 2, 2, 2>(a, lds);
      } else if (type == 2) {
        const int g = head >> 1; const float sc = 0.08838834764831845f;
        a.Q = P + (size_t)qrow0 * LDP + C_WQ + head * 128; a.ldq = LDP; a.K = P + C_WK + g * 128; a.ldk = LDP; a.V = P + C_WV + g * 128; a.ldv = LDP;
        a.C = sc * L2E; a.thrs = 8.f / sc; a.O = ATT + (size_t)qrow0 * DM + 1024 + head * 128;
        a.sinkl2 = p.in[18][l * 4 + head] * L2E; a.rc = c128; a.rs = s128;
        if (!isctx) { const int q0 = qb * 256; const int ks = (qb == 0) ? 0 : q0 - 128; const int ke = (qb == 15) ? SEQ : q0 + 384;
          a.q0 = __builtin_amdgcn_readfirstlane(q0); a.kstart = __builtin_amdgcn_readfirstlane(ks); a.lrow0 = __builtin_amdgcn_readfirstlane(b * SEQ + ks); a.NT = __builtin_amdgcn_readfirstlane(4 + (ke - ks) / 64); }
        attn_unit<128, 3, 2, 2>(a, lds);
      } else {
        const float sc = 0.07216878364870322f;
        a.Q = QM + (size_t)qrow0 * LDQM + head * 192; a.ldq = LDQM; a.K = KVM + head * 256; a.ldk = LDKVM; a.K2 = P + C_MKR; a.ldk2 = LDP; a.V = KVM + head * 256 + 128; a.ldv = LDKVM;
        a.C = sc * L2E; a.thrs = 8.f / sc; a.O = ATT + (size_t)qrow0 * DM + 1536 + head * 128;
        attn_unit<192, 0, 1, 2>(a, lds);
      }
    }
  }
}

__device__ __forceinline__ char* wsp(const Params& p) { char* w = p.ws; asm volatile("" : "+s"(w)); return w; }
__global__ void __launch_bounds__(512) fwd_megakernel(Params p) {
  extern __shared__ __attribute__((aligned(16))) char shm[];
  cg::grid_group grid = cg::this_grid();
  LAS unsigned char* ldsg = (LAS unsigned char*)shm;
  volatile LAS unsigned* xst = (volatile LAS unsigned*)(ldsg + pg8::STAGE_BYTES);
  if (threadIdx.x == 0) { xst[0] = 0u; xst[1] = 0u; }
  __syncthreads();
  const XcdBarrier xbar = xcd_barrier_post((unsigned*)(p.ws + WS_BAR), xst);
  phase0(p, shm);
  grid.sync();
  { char* ws = wsp(p); const float* mod = (const float*)(ws + WS_MOD);
    RowArgs a; a.xlat_in = p.in[0]; a.xctx_in = p.in[2]; a.xlat_out = p.out; a.xctx_out = (float*)(ws + WS_XC); a.xlat_in16 = nullptr; a.xlat_out16 = nullptr; a.Y = nullptr; a.gpost = nullptr; a.gate = nullptr;
    a.H = (bf16_t*)(ws + WS_H); a.gnext = p.in[6]; a.shift = mod + 0 * DM; a.scale = mod + 1 * DM; a.M = NROWS; a.r0 = 0; a.vb = obid(); a.vG = gridDim.x; row_phase(a); }
  xcd_barrier(xbar);
  for (int l0 = 0; l0 < 2; ++l0) {
    int l = l0; asm volatile("" : "+s"(l));
    const bool last = (l == 1);
    const int Mr = last ? NLAT : NROWS;
    { char* ws = wsp(p); pg8::StaticOrder S; pg8::Gemm g{(const bf16_t*)(ws + WS_H), (const bf16_t*)(ws + WS_W + (size_t)l * SZ_WL + OFF_WIN), NROWS, LDP, DM, DM};
      S.init(g.M, g.N, gridDim.x, obid()); pg8::EpiBf16 e{(bf16_t*)(ws + WS_P), LDP}; pg8::gemm_phase(ldsg, g, S, e); }
    xcd_barrier(xbar);
    prep_phase(p, l);
    xcd_barrier(xbar);
    { char* ws = wsp(p); pg8::StaticOrder S; pg8::Gemm g{(const bf16_t*)(ws + WS_P) + C_MQ, (const bf16_t*)(ws + WS_W + (size_t)l * SZ_WL + OFF_WUQ), NROWS, 768, 512, LDP};
      S.init(g.M, g.N, gridDim.x, obid()); pg8::EpiBf16 e{(bf16_t*)(ws + WS_QM), LDQM}; pg8::gemm_phase(ldsg, g, S, e); }
    { char* ws = wsp(p); pg8::StaticOrder S; pg8::Gemm g{(const bf16_t*)(ws + WS_P) + C_MKV, (const bf16_t*)(ws + WS_W + (size_t)l * SZ_WL + OFF_WUKV), NROWS, 1024, 256, LDP};
      S.init(g.M, g.N, gridDim.x, obid()); pg8::EpiBf16 e{(bf16_t*)(ws + WS_KVM), LDKVM}; pg8::gemm_phase(ldsg, g, S, e); }
    xcd_barrier(xbar);
    attn_phase(p, l, !last, shm);
    xcd_barrier(xbar);
    const bool cx = !last; const int bid = obid(), G = gridDim.x;
    { char* ws = wsp(p); pg8::StaticOrder S; pg8::Gemm g{(const bf16_t*)(ws + WS_ATT), (const bf16_t*)(ws + WS_W + (size_t)l * SZ_WL + OFF_WOUT), NLAT, DM, DM, DM};
      S.init(g.M, g.N, G, bid); pg8::EpiBf16 e{(bf16_t*)(ws + WS_Y), DM}; pg8::gemm_phase(ldsg, g, S, e); }
    xcd_barrier(xbar);
    if (cx && bid < 64) {
      char* ws = wsp(p); pg8::StaticOrder S; pg8::Gemm g{(const bf16_t*)(ws + WS_ATT) + (size_t)NLAT * DM, (const bf16_t*)(ws + WS_W + (size_t)l * SZ_WL + OFF_WOUT), NCTX, DM, DM, DM};
      S.init(g.M, g.N, 64, bid); pg8::EpiBf16 e{(bf16_t*)(ws + WS_Y) + (size_t)NLAT * DM, DM}; pg8::gemm_phase(ldsg, g, S, e);
    } else {
      {
        char* ws = wsp(p); const float* modl = (const float*)(ws + WS_MOD) + (size_t)l * 9 * 12288;
        RowArgs a; a.xlat_in = p.in[0]; a.xctx_in = (l == 0) ? p.in[2] : (const float*)(ws + WS_XC); a.xlat_out = p.out; a.xctx_out = (float*)(ws + WS_XC);
        a.xlat_in16 = (l == 0) ? nullptr : (const bf16_t*)p.out; a.xlat_out16 = (bf16_t*)(ws + WS_ATT);
        a.Y = (const bf16_t*)(ws + WS_Y); a.gpost = p.in[7] + l * DM; a.gate = modl + 2 * DM;
        a.H = (bf16_t*)(ws + WS_H); a.gnext = p.in[8] + l * DM; a.shift = modl + 3 * DM; a.scale = modl + 4 * DM;
        a.r0 = 0; a.M = NLAT; a.vb = cx ? bid - 64 : bid; a.vG = cx ? G - 64 : G; row_phase(a);
      }
    }
    xcd_barrier(xbar);
    if (cx) {
      char* ws = wsp(p); const float* modl = (const float*)(ws + WS_MOD) + (size_t)l * 9 * 12288;
      RowArgs a; a.xlat_in = p.in[0]; a.xctx_in = p.in[2]; a.xlat_out = p.out; a.xctx_out = (float*)(ws + WS_XC); a.xlat_in16 = nullptr; a.xlat_out16 = nullptr;
      a.Y = (const bf16_t*)(ws + WS_Y); a.gpost = p.in[7] + l * DM; a.gate = modl + 2 * DM;
      a.H = (bf16_t*)(ws + WS_H); a.gnext = p.in[8] + l * DM; a.shift = modl + 3 * DM; a.scale = modl + 4 * DM;
      a.r0 = NLAT; a.M = NROWS; a.vb = bid; a.vG = G; row_phase(a);
      xcd_barrier(xbar);
    }
    { char* ws = wsp(p); pg8::StaticOrder S; pg8::Gemm g{(const bf16_t*)(ws + WS_H), (const bf16_t*)(ws + WS_W + (size_t)l * SZ_WL + OFF_WGU), Mr, 2 * DFF, DM, DM};
      S.init(g.M, g.N, G, bid); pg8::EpiSwiGLU e{(bf16_t*)(ws + WS_U), DFF}; pg8::gemm_phase(ldsg, g, S, e); }
    xcd_barrier(xbar);
    { char* ws = wsp(p); pg8::StaticOrder S; pg8::Gemm g{(const bf16_t*)(ws + WS_U), (const bf16_t*)(ws + WS_W + (size_t)l * SZ_WL + OFF_WDN), NLAT, DM, DFF, DFF};
      S.init(g.M, g.N, G, bid); pg8::EpiBf16 e{(bf16_t*)(ws + WS_H), DM}; pg8::gemm_phase(ldsg, g, S, e); }
    xcd_barrier(xbar);
    if (cx && bid < 64) {
      char* ws = wsp(p); pg8::StaticOrder S; pg8::Gemm g{(const bf16_t*)(ws + WS_U) + (size_t)NLAT * DFF, (const bf16_t*)(ws + WS_W + (size_t)l * SZ_WL + OFF_WDN), NCTX, DM, DFF, DFF};
      S.init(g.M, g.N, 64, bid); pg8::EpiBf16 e{(bf16_t*)(ws + WS_H) + (size_t)NLAT * DM, DM}; pg8::gemm_phase(ldsg, g, S, e);
    } else {
      char* ws = wsp(p); const float* modl = (const float*)(ws + WS_MOD) + (size_t)l * 9 * 12288;
      RowArgs a; a.xlat_in = p.out; a.xctx_in = (const float*)(ws + WS_XC); a.xlat_out = p.out; a.xctx_out = (float*)(ws + WS_XC);
      a.xlat_in16 = (const bf16_t*)(ws + WS_ATT); a.xlat_out16 = last ? nullptr : (bf16_t*)p.out;
      a.Y = (const bf16_t*)(ws + WS_H); a.gpost = p.in[9] + l * DM; a.gate = modl + 5 * DM;
      a.H = last ? nullptr : (bf16_t*)(ws + WS_H); a.gnext = last ? nullptr : p.in[6] + (l + 1) * DM;
      a.shift = last ? nullptr : modl + 9 * 12288 + 0 * DM; a.scale = last ? nullptr : modl + 9 * 12288 + 1 * DM;
      a.r0 = 0; a.M = NLAT; a.vb = cx ? bid - 64 : bid; a.vG = cx ? G - 64 : G; row_phase(a);
    }
    if (cx) {
      xcd_barrier(xbar);
      char* ws = wsp(p); const float* modl = (const float*)(ws + WS_MOD) + (size_t)l * 9 * 12288;
      RowArgs a; a.xlat_in = p.out; a.xctx_in = (const float*)(ws + WS_XC); a.xlat_out = p.out; a.xctx_out = (float*)(ws + WS_XC); a.xlat_in16 = nullptr; a.xlat_out16 = nullptr;
      a.Y = (const bf16_t*)(ws + WS_H); a.gpost = p.in[9] + l * DM; a.gate = modl + 5 * DM;
      a.H = (bf16_t*)(ws + WS_H); a.gnext = p.in[6] + (l + 1) * DM; a.shift = modl + 9 * 12288 + 0 * DM; a.scale = modl + 9 * 12288 + 1 * DM;
      a.r0 = NLAT; a.M = NROWS; a.vb = bid; a.vG = G; row_phase(a);
    }
    if (!last) xcd_barrier(xbar);
  }
}

extern "C" void kernel_launch(void* const* d_in, const int* in_sizes, int n_in, void* d_out, int out_size, void* d_ws, size_t ws_size, hipStream_t stream) {
  constexpr size_t kDynLds = pg8::STAGE_BYTES + 64;
  static int ready = 0;
  if (!ready) {
    if (n_in != 27 || ws_size < WS_END) { fprintf(stderr, "kernel_launch: unexpected n_in %d / ws_size %zu (need %zu)\n", n_in, ws_size, (size_t)WS_END); return; }
    if (hipFuncSetAttribute((const void*)fwd_megakernel, hipFuncAttributeMaxDynamicSharedMemorySize, (int)kDynLds) != hipSuccess) { fprintf(stderr, "kernel_launch: LDS attribute failed\n"); return; }
    ready = 1;
  }
  Params p{};
  for (int i = 0; i < 27; ++i) p.in[i] = (const float*)d_in[i];
  p.out = (float*)d_out; p.ws = (char*)d_ws;
  for (int l = 0; l < 2; ++l) { const float li = (float)(0.8 - 0.6 * exp(-0.3 * (double)l)); p.lam_init[l] = li; p.one_minus_lam_init[l] = 1.0f - li; }
  if (hipMemsetAsync((char*)d_ws + WS_BAR, 0, 16384, stream) != hipSuccess) { fprintf(stderr, "kernel_launch: memset of barrier words failed\n"); return; }
  void* args[] = {&p};
  hipError_t e = hipLaunchCooperativeKernel((void*)fwd_megakernel, dim3(256), dim3(512), args, kDynLds, stream);
  if (e != hipSuccess) fprintf(stderr, "cooperative launch failed: %s\n", hipGetErrorString(e));
}
```

```cpp
#include <hip/hip_runtime.h>
#include <hip/hip_cooperative_groups.h>
#include <cstdio>
#include <cmath>
namespace cg = cooperative_groups;

typedef unsigned short bf16_t;
typedef short bf16x8 __attribute__((ext_vector_type(8)));
typedef short s16x4 __attribute__((ext_vector_type(4)));
typedef float f32x2 __attribute__((ext_vector_type(2)));
typedef float f32x4 __attribute__((ext_vector_type(4)));
typedef float f32x16 __attribute__((ext_vector_type(16)));
typedef unsigned u32x2 __attribute__((ext_vector_type(2)));
typedef unsigned u32x4 __attribute__((ext_vector_type(4)));
#define LAS __attribute__((address_space(3)))

constexpr int NLAT = 32768, NCTX = 2048, NROWS = NLAT + NCTX, DM = 2048, SEQ = 4096, CTXL = 256, NB = 8;
constexpr int INC = 4416, LDP = 4608, DFF = 5632, LDQM = 768, LDKVM = 1024;
constexpr float EPS = 1e-6f;
constexpr int C_GQ = 0, C_GK = 512, C_GV = 768, C_DQ = 1024, C_DK = 1536, C_DV = 2048, C_WQ = 2560, C_WK = 3072, C_WV = 3328, C_MQ = 3584, C_MKV = 4096, C_MKR = 4352;

constexpr size_t al256(size_t x) { return (x + 255) / 256 * 256; }
constexpr size_t SZ_WIN = (size_t)LDP * DM * 2, SZ_WUQ = (size_t)768 * 512 * 2, SZ_WUKV = (size_t)1024 * 256 * 2, SZ_WOUT = (size_t)DM * DM * 2,
                 SZ_WGU = (size_t)2 * DFF * DM * 2, SZ_WDN = (size_t)DM * DFF * 2;
constexpr size_t OFF_WIN = 0, OFF_WUQ = OFF_WIN + SZ_WIN, OFF_WUKV = OFF_WUQ + SZ_WUQ, OFF_WOUT = OFF_WUKV + SZ_WUKV, OFF_WGU = OFF_WOUT + SZ_WOUT,
                 OFF_WDN = OFF_WGU + SZ_WGU, SZ_WL = OFF_WDN + SZ_WDN;
constexpr size_t WS_W = 0;
constexpr size_t WS_MOD = al256(WS_W + 2 * SZ_WL);
constexpr size_t WS_ROPE = al256(WS_MOD + (size_t)2 * 9 * 12288 * 4);
constexpr size_t SZ_R128 = (size_t)4096 * 64 * 4, SZ_R64 = (size_t)4096 * 32 * 4;
constexpr size_t WS_MISC = al256(WS_ROPE + 2 * SZ_R128 + 2 * SZ_R64);
constexpr size_t WS_H = al256(WS_MISC + 256);
constexpr size_t WS_P = al256(WS_H + (size_t)NROWS * DM * 2);
constexpr size_t WS_QM = al256(WS_P + (size_t)NROWS * LDP * 2);
constexpr size_t WS_KVM = al256(WS_QM + (size_t)NROWS * LDQM * 2);
constexpr size_t WS_PEND = al256(WS_KVM + (size_t)NROWS * LDKVM * 2);
constexpr size_t WS_ATT = WS_PEND;
constexpr size_t WS_XC = al256(WS_ATT + (size_t)NROWS * DM * 2);
constexpr size_t WS_TMP = al256(WS_XC + (size_t)NCTX * DM * 4);
constexpr size_t WS_BAR = al256(WS_TMP + (size_t)256 * 256 * 128 * 4);
constexpr size_t WS_END = WS_BAR + 16384;
constexpr size_t WS_Y = WS_P;
constexpr size_t WS_U = WS_P;
static_assert((size_t)NROWS * DFF * 2 <= WS_PEND - WS_P, "U must fit in P region");

struct Params {
  const float* in[27];
  float* out;
  char* ws;
  float lam_init[2];
  float one_minus_lam_init[2];
};

__device__ __forceinline__ char* wsp(const Params& p);
__device__ __forceinline__ int otid() { int t = threadIdx.x; asm volatile("" : "+v"(t)); return t; }
__device__ __forceinline__ int obid() { int b = blockIdx.x; asm volatile("" : "+s"(b)); return b; }
__device__ __forceinline__ unsigned cvtpk(float lo, float hi) { unsigned r; asm volatile("v_cvt_pk_bf16_f32 %0, %1, %2" : "=v"(r) : "v"(lo), "v"(hi)); return r; }
__device__ __forceinline__ float bflo(unsigned u) { return __uint_as_float(u << 16); }
__device__ __forceinline__ float bfhi(unsigned u) { return __uint_as_float(u & 0xffff0000u); }
__device__ __forceinline__ float shflx(float v, int m, int lane) { return __int_as_float(__builtin_amdgcn_ds_bpermute((lane ^ m) << 2, __float_as_int(v))); }
__device__ __forceinline__ float wave_sum64(float v, int lane) {
  v += shflx(v, 1, lane); v += shflx(v, 2, lane); v += shflx(v, 4, lane); v += shflx(v, 8, lane); v += shflx(v, 16, lane); v += shflx(v, 32, lane); return v; }
__device__ __forceinline__ float half_sum32(float v, int lane) {
  v += shflx(v, 1, lane); v += shflx(v, 2, lane); v += shflx(v, 4, lane); v += shflx(v, 8, lane); v += shflx(v, 16, lane); return v; }


#define XB_TMO      128
#define XB_XCNT(j)  (256  + 64 * (j))
#define XB_XSUB(j)  (1280 + 64 * (j))
#define XB_XGEN(j)  (2304 + 64 * (j))
#define XB_TOP      3328
#define XB_TOPGEN   3392
#define XCD_BAR_WORDS 3456
#define XB_SPIN_CAP (1u << 18)
__device__ __forceinline__ unsigned xb_ld(unsigned* p)              { return __hip_atomic_load(p, __ATOMIC_RELAXED, __HIP_MEMORY_SCOPE_AGENT); }
__device__ __forceinline__ unsigned xb_add(unsigned* p, unsigned v) { return __hip_atomic_fetch_add(p, v, __ATOMIC_RELAXED, __HIP_MEMORY_SCOPE_AGENT); }
__device__ __forceinline__ unsigned xb_xcc_id() { return (unsigned)__builtin_amdgcn_s_getreg((3 << 11) | 20) & 0xFu; }
#define XB_SPIN(cond, bar) do { unsigned _sp = 0; while (cond) { __builtin_amdgcn_s_sleep(1); \
    if ((++_sp & 255u) == 0u) { if (xb_ld(&(bar)[XB_TMO])) break; if (_sp > XB_SPIN_CAP) { atomicAdd(&(bar)[XB_TMO], 1u); break; } } } } while (0)
struct XcdBarrier { unsigned* bar; unsigned x; volatile LAS unsigned* st; };
__device__ __forceinline__ XcdBarrier xcd_barrier_post(unsigned* bar, volatile LAS unsigned* st) {
  XcdBarrier b; b.bar = bar; b.x = (unsigned)__builtin_amdgcn_readfirstlane((int)xb_xcc_id()); b.st = st;
  if (threadIdx.x == 0) (void)xb_add(&bar[XB_XCNT(b.x)], 1u);
  return b;
}
__device__ __forceinline__ void xcd_barrier_complete(unsigned* bar, unsigned x, unsigned& nloc, unsigned& nx) {
  const unsigned G = gridDim.x * gridDim.y * gridDim.z;
  unsigned sum, cnt, mine, sp = 0u;
  for (;;) {
    sum = 0u; cnt = 0u; mine = 0u;
#pragma unroll
    for (unsigned j = 0; j < 16; ++j) { const unsigned c = xb_ld(&bar[XB_XCNT(j)]); sum += c; cnt += (c > 0u) ? 1u : 0u; mine = (j == x) ? c : mine; }
    if (sum == G) break;
    __builtin_amdgcn_s_sleep(1);
    if ((++sp & 255u) == 0u) { if (xb_ld(&bar[XB_TMO])) break; if (sp > XB_SPIN_CAP) { atomicAdd(&bar[XB_TMO], 1u); break; } }
  }
  nloc = mine > 0u ? mine : 1u; nx = cnt > 0u ? cnt : 1u;
}
__device__ __forceinline__ void xcd_barrier(const XcdBarrier& b) {
  asm volatile("s_waitcnt vmcnt(0)" ::: "memory");
  __syncthreads();
  if (threadIdx.x == 0) {
    unsigned* bar = b.bar;
    const unsigned bx = (unsigned)__builtin_amdgcn_readfirstlane((int)xb_xcc_id());
    __builtin_amdgcn_s_waitcnt(0);
    unsigned nloc = b.st[0], nx = b.st[1];
    if (nloc == 0u) { xcd_barrier_complete(bar, bx, nloc, nx); b.st[0] = nloc; b.st[1] = nx; }
    const unsigned old = xb_add(&bar[XB_XSUB(bx)], 1u);
    const unsigned gen = old / nloc;
    if (old + 1u == (gen + 1u) * nloc) {
      __builtin_amdgcn_fence(__ATOMIC_RELEASE, "agent");
      asm volatile("s_waitcnt vmcnt(0)" ::: "memory");
      const unsigned og = xb_add(&bar[XB_TOP], 1u);
      const unsigned tg = og / nx;
      if (og + 1u == (tg + 1u) * nx) xb_add(&bar[XB_TOPGEN], 1u);
      else XB_SPIN(xb_ld(&bar[XB_TOPGEN]) == tg, bar);
      __builtin_amdgcn_fence(__ATOMIC_ACQUIRE, "agent");
      xb_add(&bar[XB_XGEN(bx)], 1u);
      asm volatile("s_waitcnt vmcnt(0)" ::: "memory");
    } else {
      XB_SPIN(xb_ld(&bar[XB_XGEN(bx)]) == gen, bar);
      __builtin_amdgcn_fence(__ATOMIC_ACQUIRE, "agent");
      asm volatile("s_waitcnt vmcnt(0)" ::: "memory");
    }
  }
  __syncthreads();
}

namespace pg8 {
constexpr int BM = 256, BK = 64, HALF = 128, HTB = HALF * BK * 2, STAGE_BYTES = 8 * HTB, NXCD = 8, WGM = 8;
__device__ __forceinline__ int lds_byte(int r, int c) { const int st = (r >> 4) * 2 + (c >> 5), rr = r & 15, cc = c & 31, ob = rr * 64 + cc * 2; return st * 1024 + (ob ^ (((ob >> 9) & 1) << 5)); }
__device__ __forceinline__ void stage_rc(int b, int& R, int& C) { const int st = b / 1024, sb = b % 1024, swz = sb ^ (((sb >> 9) & 1) << 5); R = (st >> 1) * 16 + swz / 64; C = (st & 1) * 32 + (swz % 64) / 2; }
__device__ __forceinline__ int perm32(int rho) { const int n = rho >> 4, i = rho & 15; return 8 * (i >> 2) + 4 * n + (i & 3); }
struct Unit { int pm, pn; };
struct Gemm { const bf16_t* A; const bf16_t* Bt; int M, N, K, lda; };
struct StaticOrder {
  int nM, nN, nwg, G, c;
  __device__ void init(int M, int N, int G_, int c_) { nM = M / BM; nN = N / BM; nwg = nM * nN; G = G_; c = c_; }
  __device__ bool next(int i, Unit& u) const {
    const long L = (long)i * G + c; if (L >= nwg) return false;
    int wgid = (int)L; { const int q = nwg / NXCD, r = nwg % NXCD, xcd = wgid % NXCD, off = wgid / NXCD; wgid = (xcd < r ? xcd * (q + 1) : r * (q + 1) + (xcd - r) * q) + off; }
    const int nig = WGM * nN, gid = wgid / nig, fm = gid * WGM, gsz = (nM - fm) < WGM ? (nM - fm) : WGM;
    u.pm = fm + ((wgid % nig) % gsz); u.pn = (wgid % nig) / gsz; return true;
  }
};
struct EpiBf16 {
  static constexpr int NST = 16;
  bf16_t* O; int ldc;
  __device__ __forceinline__ void operator()(const f32x4 (&acc)[2][2][4][2], const Unit& u, int wr, int wc, int fr, int fq) const {
    const int row0 = u.pm * BM + wr * 64 + fr, col0 = u.pn * BM + wc * 32 + 8 * fq;
#pragma unroll
    for (int ai = 0; ai < 2; ++ai)
#pragma unroll
      for (int m = 0; m < 4; ++m) { bf16_t* rowp = O + (size_t)(row0 + ai * HALF + m * 16) * ldc + col0;
#pragma unroll
        for (int bj = 0; bj < 2; ++bj) { const f32x4 v0 = acc[ai][bj][m][0], v1 = acc[ai][bj][m][1];
          u32x4 w; w.x = cvtpk(v0[0], v0[1]); w.y = cvtpk(v0[2], v0[3]); w.z = cvtpk(v1[0], v1[1]); w.w = cvtpk(v1[2], v1[3]);
          *(u32x4*)(rowp + bj * HALF) = w; } }
  }
};
__device__ __forceinline__ float swiglu1(float g, float u) { return g * __builtin_amdgcn_rcpf(1.0f + __builtin_amdgcn_exp2f(-1.4426950408889634f * g)) * u; }
struct EpiSwiGLU {
  static constexpr int NST = 8;
  bf16_t* O; int ldc;
  __device__ __forceinline__ void operator()(const f32x4 (&acc)[2][2][4][2], const Unit& u, int wr, int wc, int fr, int fq) const {
    const int row0 = u.pm * BM + wr * 64 + fr, col0 = u.pn * HALF + wc * 32 + 8 * fq;
#pragma unroll
    for (int ai = 0; ai < 2; ++ai)
#pragma unroll
      for (int m = 0; m < 4; ++m) { bf16_t* rowp = O + (size_t)(row0 + ai * HALF + m * 16) * ldc + col0;
        const f32x4 g0 = acc[ai][0][m][0], g1 = acc[ai][0][m][1], u0 = acc[ai][1][m][0], u1 = acc[ai][1][m][1];
        u32x4 w; w.x = cvtpk(swiglu1(g0[0], u0[0]), swiglu1(g0[1], u0[1])); w.y = cvtpk(swiglu1(g0[2], u0[2]), swiglu1(g0[3], u0[3]));
        w.z = cvtpk(swiglu1(g1[0], u1[0]), swiglu1(g1[1], u1[1])); w.w = cvtpk(swiglu1(g1[2], u1[2]), swiglu1(g1[3], u1[3]));
        *(u32x4*)rowp = w; }
  }
};

template <class Epi>
__device__ __forceinline__ void gemm_phase(LAS unsigned char* lds, const Gemm g, const StaticOrder& S, const Epi& E) {
  int tid = threadIdx.x; asm volatile("" : "+v"(tid));
  const int wid = __builtin_amdgcn_readfirstlane(tid >> 6), lane = tid & 63, wr = wid >> 2, wc = wid & 3, fr = lane & 15, fq = lane >> 4;
  const int K = g.K, nt = K / BK, lda = g.lda;
  unsigned voffA, voffB;
  { int R, C; stage_rc(tid * 16, R, C); const int Rb = (R & ~31) + perm32(R & 31);
    voffA = (unsigned)(R * lda + C) * 2u; voffB = (unsigned)(Rb * K + C) * 2u; }
  const size_t r64A = (size_t)64 * lda * 2, r64B = (size_t)64 * K * 2;
  const size_t kstep = (size_t)(BK * 2);
  const size_t hstepA = (size_t)HALF * lda * 2, tstepA = 2 * hstepA;
  const size_t hstepB = (size_t)HALF * K * 2, tstepB = 2 * hstepB;
  const unsigned ldsw = (unsigned)wid * 1024u;
  const int aoff = lds_byte(wr * 64 + fr, fq * 8), boff = lds_byte(wc * 32 + fr, fq * 8);
#define PG8_R64_voffA r64A
#define PG8_R64_voffB r64B
#define PG8_SA(b, h) (((b) * 2 + (h)) * HTB)
#define PG8_SB(b, h) ((4 + (b) * 2 + (h)) * HTB)
#define PG8_STAGE(bufoff, gbase, voff) do { \
    __builtin_amdgcn_global_load_lds((const unsigned*)((const char*)(gbase) + (voff)), (LAS unsigned*)(lds + (bufoff) + ldsw), 16, 0, 0); \
    __builtin_amdgcn_global_load_lds((const unsigned*)((const char*)(gbase) + PG8_R64(voff) + (voff)), (LAS unsigned*)(lds + (bufoff) + ldsw + 8192), 16, 0, 0); } while (0)
#define PG8_R64(voff) PG8_R64_##voff
#define PG8_LDA(dst, b, h) do { _Pragma("unroll") for (int m = 0; m < 4; ++m) _Pragma("unroll") for (int k = 0; k < 2; ++k) dst[m][k] = *(const LAS bf16x8*)(lds + PG8_SA(b, h) + aoff + m * 2048 + k * 1024); } while (0)
#define PG8_LDB(dst, b, h) do { _Pragma("unroll") for (int n = 0; n < 2; ++n) _Pragma("unroll") for (int k = 0; k < 2; ++k) dst[n][k] = *(const LAS bf16x8*)(lds + PG8_SB(b, h) + boff + n * 2048 + k * 1024); } while (0)
#define PG8_MMA(ai, bj, At, Bt) do { __builtin_amdgcn_s_setprio(1); _Pragma("unroll") for (int m = 0; m < 4; ++m) _Pragma("unroll") for (int n = 0; n < 2; ++n) _Pragma("unroll") for (int k = 0; k < 2; ++k) \
    acc[ai][bj][m][n] = __builtin_amdgcn_mfma_f32_16x16x32_bf16(Bt[n][k], At[m][k], acc[ai][bj][m][n], 0, 0, 0); __builtin_amdgcn_s_setprio(0); } while (0)
#define PG8_WAIT_V(n) asm volatile("s_waitcnt vmcnt(" #n ")" ::: "memory")
#define PG8_WAIT_L(n) asm volatile("s_waitcnt lgkmcnt(" #n ")" ::: "memory")
#define PG8_BAR __builtin_amdgcn_s_barrier()
#define PG8_SCHED __builtin_amdgcn_sched_barrier(0)
  Unit cur, nxt; int ui = 0;
  if (!S.next(0, cur)) return;
  f32x4 acc[2][2][4][2];
#pragma unroll
  for (int a = 0; a < 2; ++a)
#pragma unroll
    for (int b = 0; b < 2; ++b)
#pragma unroll
      for (int m = 0; m < 4; ++m)
#pragma unroll
        for (int n = 0; n < 2; ++n) acc[a][b][m][n] = (f32x4){0.f, 0.f, 0.f, 0.f};
  bf16x8 At[4][2], B0[2][2], B1[2][2];
  const char* cA = (const char*)g.A + (size_t)cur.pm * tstepA; const char* cB = (const char*)g.Bt + (size_t)cur.pn * tstepB;
  PG8_STAGE(PG8_SB(0, 0), cB, voffB); PG8_STAGE(PG8_SA(0, 0), cA, voffA); PG8_STAGE(PG8_SB(0, 1), cB + hstepB, voffB); PG8_STAGE(PG8_SA(0, 1), cA + hstepA, voffA);
  if (wr == 1) PG8_BAR;
  PG8_WAIT_V(4); PG8_BAR;
  PG8_STAGE(PG8_SB(1, 0), cB + kstep, voffB); PG8_STAGE(PG8_SA(1, 0), cA + kstep, voffA); PG8_STAGE(PG8_SB(1, 1), cB + hstepB + kstep, voffB);
  PG8_WAIT_V(6); PG8_BAR;
  PG8_STAGE(PG8_SA(1, 1), cA + kstep + hstepA, voffA);
  for (;;) {
    const bool has_next = S.next(ui + 1, nxt);
    const char* nA = has_next ? (const char*)g.A + (size_t)nxt.pm * tstepA : cA; const char* nB = has_next ? (const char*)g.Bt + (size_t)nxt.pn * tstepB : cB;
    for (int t = 0; t < nt; t += 2) {
      const bool last = (t == nt - 2);
      const char* a2 = last ? nA : cA + (size_t)(t + 2) * kstep; const char* b2 = last ? nB : cB + (size_t)(t + 2) * kstep;
      const char* a3 = a2 + kstep; const char* b3 = b2 + kstep;
      PG8_LDB(B0, 0, 0); PG8_SCHED; PG8_LDA(At, 0, 0);
      PG8_WAIT_L(8); PG8_BAR; PG8_WAIT_L(0); PG8_MMA(0, 0, At, B0); PG8_BAR; PG8_SCHED;
      PG8_LDB(B1, 0, 1); PG8_STAGE(PG8_SB(0, 0), b2, voffB);
      PG8_BAR; PG8_WAIT_L(0); PG8_MMA(0, 1, At, B1); PG8_BAR;
      PG8_LDA(At, 0, 1); PG8_STAGE(PG8_SA(0, 0), a2, voffA);
      PG8_BAR; PG8_WAIT_L(0); PG8_MMA(1, 0, At, B0); PG8_BAR; PG8_SCHED;
      PG8_STAGE(PG8_SB(0, 1), b2 + hstepB, voffB);
      if ((ui | t) != 0 && t == 0) asm volatile("s_waitcnt vmcnt(%0)" :: "n"(6 + Epi::NST) : "memory"); else PG8_WAIT_V(6);
      PG8_BAR; PG8_MMA(1, 1, At, B1); PG8_BAR;
      PG8_LDB(B0, 1, 0); PG8_SCHED; PG8_LDA(At, 1, 0); PG8_STAGE(PG8_SA(0, 1), a2 + hstepA, voffA);
      PG8_WAIT_L(8); PG8_BAR; PG8_WAIT_L(0); PG8_MMA(0, 0, At, B0); PG8_BAR; PG8_SCHED;
      PG8_LDB(B1, 1, 1); PG8_STAGE(PG8_SB(1, 0), b3, voffB);
      PG8_BAR; PG8_WAIT_L(0); PG8_MMA(0, 1, At, B1); PG8_BAR;
      PG8_LDA(At, 1, 1); PG8_STAGE(PG8_SA(1, 0), a3, voffA);
      PG8_BAR; PG8_WAIT_L(0); PG8_MMA(1, 0, At, B0); PG8_BAR; PG8_SCHED;
      PG8_STAGE(PG8_SB(1, 1), b3 + hstepB, voffB);
      PG8_WAIT_V(6); PG8_BAR; PG8_MMA(1, 1, At, B1); PG8_BAR;
      PG8_STAGE(PG8_SA(1, 1), a3 + hstepA, voffA);
    }
    { int t2 = tid; asm volatile("" : "+v"(t2));
      const int w2 = t2 >> 6, l2 = t2 & 63; E(acc, cur, w2 >> 2, w2 & 3, l2 & 15, l2 >> 4); }
    if (!has_next) break;
#pragma unroll
    for (int a = 0; a < 2; ++a)
#pragma unroll
      for (int b = 0; b < 2; ++b)
#pragma unroll
        for (int m = 0; m < 4; ++m)
#pragma unroll
          for (int n = 0; n < 2; ++n) acc[a][b][m][n] = (f32x4){0.f, 0.f, 0.f, 0.f};
    cur = nxt; cA = nA; cB = nB; ++ui;
  }
  PG8_WAIT_V(0);
  if (wr == 0) PG8_BAR;
  PG8_BAR;
#undef PG8_R64
#undef PG8_R64_voffA
#undef PG8_R64_voffB
#undef PG8_SA
#undef PG8_SB
#undef PG8_STAGE
#undef PG8_LDA
#undef PG8_LDB
#undef PG8_MMA
#undef PG8_WAIT_V
#undef PG8_WAIT_L
#undef PG8_BAR
#undef PG8_SCHED
}
}

constexpr size_t SHM_V = 64 * 128 * 2;
#define SBAR() __builtin_amdgcn_sched_barrier(0)
__device__ __forceinline__ int crow(int r, int hi) { return (r & 3) + 8 * (r >> 2) + 4 * hi; }
__device__ __forceinline__ void partialSM(f32x16& p0, f32x16& p1, float& m_reg, float& mn, float& alpha, float C, float thrs) {
  float pmax = p0[0];
#pragma unroll
  for (int r = 1; r < 16; ++r) pmax = fmaxf(pmax, p0[r]);
#pragma unroll
  for (int r = 0; r < 16; ++r) pmax = fmaxf(pmax, p1[r]);
  { auto rr = __builtin_amdgcn_permlane32_swap(__float_as_uint(pmax), __float_as_uint(pmax), false, false);
    pmax = fmaxf(__uint_as_float(rr[0]), __uint_as_float(rr[1])); }
  if (__builtin_expect(__all(pmax - m_reg <= thrs), 1)) { mn = m_reg; alpha = 1.f; }
  else { mn = fmaxf(m_reg, pmax); alpha = __builtin_amdgcn_exp2f((m_reg - mn) * C); m_reg = mn; }
  float mnC = -mn * C;
#pragma unroll
  for (int r = 0; r < 16; ++r) p0[r] = fmaf(p0[r], C, mnC);
#pragma unroll
  for (int r = 0; r < 16; ++r) p1[r] = fmaf(p1[r], C, mnC);
#pragma unroll
  for (int r = 0; r < 16; ++r) p0[r] = __builtin_amdgcn_exp2f(p0[r]);
}
__device__ __forceinline__ void finishSM(f32x16& p0, f32x16& p1, float alpha, float& l_reg, bf16x8& pa0, bf16x8& pa1, bf16x8& pa2, bf16x8& pa3) {
#pragma unroll
  for (int r = 0; r < 16; ++r) p1[r] = __builtin_amdgcn_exp2f(p1[r]);
  float ps = 0;
#pragma unroll
  for (int r = 0; r < 16; ++r) ps += p0[r];
#pragma unroll
  for (int r = 0; r < 16; ++r) ps += p1[r];
  { auto rr = __builtin_amdgcn_permlane32_swap(__float_as_uint(ps), __float_as_uint(ps), false, false);
    ps = __uint_as_float(rr[0]) + __uint_as_float(rr[1]); }
  l_reg = l_reg * alpha + ps;
#define PK4(P, BASE, OUT) do { unsigned a0 = cvtpk(P[BASE + 0], P[BASE + 1]), a1 = cvtpk(P[BASE + 2], P[BASE + 3]);   \
    unsigned b0 = cvtpk(P[BASE + 4], P[BASE + 5]), b1 = cvtpk(P[BASE + 6], P[BASE + 7]);                              \
    auto r0 = __builtin_amdgcn_permlane32_swap(a0, b0, false, false); auto r1 = __builtin_amdgcn_permlane32_swap(a1, b1, false, false); \
    u32x4 w = {r0[0], r1[0], r0[1], r1[1]}; OUT = *reinterpret_cast<bf16x8*>(&w); } while (0)
  PK4(p0, 0, pa0); PK4(p0, 8, pa1); PK4(p1, 0, pa2); PK4(p1, 8, pa3);
#undef PK4
}
template <int DQK> __device__ __forceinline__ int kswz(int row, int colB) { return row * (DQK * 2) + (colB ^ ((row & 7) << 4)); }
template <int DQK>
__device__ __forceinline__ void qkt(f32x16& p0, f32x16& p1, const char* Ks, const bf16x8* qr, int r32, int hi) {
  p0 = f32x16{}; p1 = f32x16{};
#pragma unroll
  for (int d0 = 0; d0 < DQK / 16; ++d0) { int cb = (d0 * 16 + hi * 8) * 2;
    bf16x8 b0 = *reinterpret_cast<const bf16x8*>(Ks + kswz<DQK>(r32, cb));
    bf16x8 b1 = *reinterpret_cast<const bf16x8*>(Ks + kswz<DQK>(32 + r32, cb));
    p0 = __builtin_amdgcn_mfma_f32_32x32x16_bf16(b0, qr[d0], p0, 0, 0, 0);
    p1 = __builtin_amdgcn_mfma_f32_32x32x16_bf16(b1, qr[d0], p1, 0, 0, 0); }
}
__device__ __forceinline__ int v_st(int k, int c) { const int kk = (k & ~0xC) | ((k & 4) << 1) | ((k & 8) >> 1); return ((kk >> 3) * 4 + (c >> 5)) * 512 + ((kk & 7) * 32 + (c & 31)) * 2; }
__device__ __forceinline__ int v_rd_base(int lane) { return ((lane & 3) << 3) | (((lane >> 2) & 3) << 6) | (((lane >> 4) & 1) << 5) | (((lane >> 5) & 1) << 8); }
constexpr int v_rd_off(int d0, int ks, int half) { return d0 * 512 + ks * 4096 + half * 2048; }
template <int OFF> __device__ __forceinline__ s16x4 tr_read(int vb) {
  s16x4 r; asm volatile("ds_read_b64_tr_b16 %0, %1 offset:%2" : "=&v"(r) : "v"(vb), "i"(OFF) : "memory"); return r;
}
template <int D0> __device__ __forceinline__ void pv_one(f32x16& od, int vb, bf16x8 pa0, bf16x8 pa1, bf16x8 pa2, bf16x8 pa3) {
  const s16x4 l0 = tr_read<v_rd_off(D0, 0, 0)>(vb), h0 = tr_read<v_rd_off(D0, 0, 1)>(vb), l1 = tr_read<v_rd_off(D0, 1, 0)>(vb), h1 = tr_read<v_rd_off(D0, 1, 1)>(vb);
  const s16x4 l2 = tr_read<v_rd_off(D0, 2, 0)>(vb), h2 = tr_read<v_rd_off(D0, 2, 1)>(vb), l3 = tr_read<v_rd_off(D0, 3, 0)>(vb), h3 = tr_read<v_rd_off(D0, 3, 1)>(vb);
  asm volatile("s_waitcnt lgkmcnt(0)" ::: "memory"); SBAR();
#define PK(L, H) (bf16x8){L[0], L[1], L[2], L[3], H[0], H[1], H[2], H[3]}
  od = __builtin_amdgcn_mfma_f32_32x32x16_bf16(pa0, PK(l0, h0), od, 0, 0, 0);
  od = __builtin_amdgcn_mfma_f32_32x32x16_bf16(pa1, PK(l1, h1), od, 0, 0, 0);
  od = __builtin_amdgcn_mfma_f32_32x32x16_bf16(pa2, PK(l2, h2), od, 0, 0, 0);
  od = __builtin_amdgcn_mfma_f32_32x32x16_bf16(pa3, PK(l3, h3), od, 0, 0, 0);
#undef PK
}
__device__ __forceinline__ void pv_d0(f32x16* o, int vb, bf16x8 pa0, bf16x8 pa1, bf16x8 pa2, bf16x8 pa3) {
  pv_one<0>(o[0], vb, pa0, pa1, pa2, pa3); pv_one<1>(o[1], vb, pa0, pa1, pa2, pa3); pv_one<2>(o[2], vb, pa0, pa1, pa2, pa3); pv_one<3>(o[3], vb, pa0, pa1, pa2, pa3);
}

struct AttnArgs {
  const bf16_t* Q; int ldq;
  const bf16_t* K; int ldk;
  const bf16_t* K2; int ldk2;
  const bf16_t* V; int ldv;
  int crow0, lrow0, NT;
  float C, thrs;
  bf16_t* O; int ldo;
  float* tmp;
  float lam, postmul; const float* subln;
  float sinkl2;
  int q0, kstart;
  const float* rc; const float* rs; int tq0;
  const float* qgain;
};
template <int DQK, int MODE, int SDEPTH, int QT>
__device__ __forceinline__ void attn_unit(const AttnArgs& a, char* lds) {
  constexpr int SHM_K = 64 * DQK * 2;
  constexpr int NLD = (DQK == 64 ? 3 : (DQK == 128 ? 4 : 5));
  int tid = threadIdx.x; asm volatile("" : "+v"(tid));
  const int wid = tid >> 6, lane = tid & 63, r32 = lane & 31, hi = lane >> 5;
  char* V_lds = lds; char* K_lds = lds + 2 * SHM_V;
  float* wsl = (float*)(lds + 2 * SHM_V + 2 * SHM_K) + wid * 64; float* li_l = wsl; float* al_l = wsl + 32;
  float m_reg = -1e30f, l_reg = 0; f32x16 o[4] = {}; bf16x8 qr[DQK / 16];
  const float C = a.C, thrs = a.thrs;
  const bf16_t* Qw = a.Q + (size_t)(wid * 32 + r32) * a.ldq + hi * 8;
#pragma unroll
  for (int d0 = 0; d0 < DQK / 16; ++d0) qr[d0] = *reinterpret_cast<const bf16x8*>(Qw + d0 * 16);
  if constexpr (QT == 1) {
    float ss = 0.f;
#pragma unroll
    for (int d0 = 0; d0 < 8; ++d0) { const u32x4 w = *reinterpret_cast<u32x4*>(&qr[d0]);
#pragma unroll
      for (int e = 0; e < 4; ++e) { const float lo = bflo(w[e]), hh = bfhi(w[e]); ss += lo * lo + hh * hh; } }
    ss += shflx(ss, 32, lane);
    const float rstd = rsqrtf(ss * (1.0f / 128.0f) + EPS);
#pragma unroll
    for (int d0 = 0; d0 < 8; ++d0) { const float* gp = a.qgain + d0 * 16 + hi * 8; const f32x4 g0 = *(const f32x4*)gp, g1 = *(const f32x4*)(gp + 4);
      const u32x4 w = *reinterpret_cast<u32x4*>(&qr[d0]); u32x4 y;
      y.x = cvtpk(bflo(w.x) * rstd * g0[0], bfhi(w.x) * rstd * g0[1]); y.y = cvtpk(bflo(w.y) * rstd * g0[2], bfhi(w.y) * rstd * g0[3]);
      y.z = cvtpk(bflo(w.z) * rstd * g1[0], bfhi(w.z) * rstd * g1[1]); y.w = cvtpk(bflo(w.w) * rstd * g1[2], bfhi(w.w) * rstd * g1[3]);
      qr[d0] = *reinterpret_cast<bf16x8*>(&y); }
  }
  if constexpr (QT != 0) {
    if (a.tq0 >= 0) {
      constexpr int RB = (DQK == 192) ? 8 : 0, RH = (DQK == 128) ? 64 : 32;
      const int t = a.tq0 + wid * 32 + r32;
#pragma unroll
      for (int g = 0; g < RH / 16; ++g) {
        const float* cp = a.rc + (size_t)t * RH + g * 16 + hi * 8; const float* sp = a.rs + (size_t)t * RH + g * 16 + hi * 8;
        const f32x4 c0 = *(const f32x4*)cp, c1 = *(const f32x4*)(cp + 4), s0 = *(const f32x4*)sp, s1 = *(const f32x4*)(sp + 4);
        const u32x4 xa = *reinterpret_cast<u32x4*>(&qr[RB + g]), xb = *reinterpret_cast<u32x4*>(&qr[RB + g + RH / 16]);
        u32x4 ya, yb;
#pragma unroll
        for (int w = 0; w < 4; ++w) {
          const float cl = w < 2 ? c0[2 * w] : c1[2 * w - 4], ch = w < 2 ? c0[2 * w + 1] : c1[2 * w - 3];
          const float sl = w < 2 ? s0[2 * w] : s1[2 * w - 4], sh = w < 2 ? s0[2 * w + 1] : s1[2 * w - 3];
          const float x1l = bflo(xa[w]), x1h = bfhi(xa[w]), x2l = bflo(xb[w]), x2h = bfhi(xb[w]);
          ya[w] = cvtpk(x1l * cl - x2l * sl, x1h * ch - x2h * sh);
          yb[w] = cvtpk(x2l * cl + x1l * sl, x2h * ch + x1h * sh);
        }
        qr[RB + g] = *reinterpret_cast<bf16x8*>(&ya); qr[RB + g + RH / 16] = *reinterpret_cast<bf16x8*>(&yb);
      }
    }
  }
  const int sr = tid >> 4, sc = (tid & 15) * 8, vst0 = v_st(sr, sc), vst1 = v_st(32 + sr, sc);
  const int kr = tid >> 3, kc = (tid & 7) * 8;
  const int vb0 = (int)(uintptr_t)V_lds + v_rd_base(lane);
  struct { bf16x8 vs0, vs1, ks0, ks1, ks2; } sr_[SDEPTH];
#define KROW(j) ((j) < 4 ? a.crow0 + (j) * 64 : a.lrow0 + ((j) - 4) * 64)
  const unsigned voV = (unsigned)(sr * a.ldv + sc) * 2u, voK = (DQK == 64) ? (unsigned)(kr * a.ldk + kc) * 2u : (unsigned)(sr * a.ldk + sc) * 2u, voK2 = (DQK == 192) ? (unsigned)(kr * a.ldk2 + kc) * 2u : 0u;
#define SLOAD(i, j) do { const int rb_ = __builtin_amdgcn_readfirstlane(KROW(j)); \
    const char* vb_ = (const char*)a.V + (size_t)rb_ * a.ldv * 2; const char* kb_ = (const char*)a.K + (size_t)rb_ * a.ldk * 2; \
    sr_[i].vs0 = *(const bf16x8*)(vb_ + voV); sr_[i].vs1 = *(const bf16x8*)(vb_ + (size_t)a.ldv * 64 + voV); \
    if constexpr (DQK == 64) { sr_[i].ks0 = *(const bf16x8*)(kb_ + voK); } \
    else { sr_[i].ks0 = *(const bf16x8*)(kb_ + voK); sr_[i].ks1 = *(const bf16x8*)(kb_ + (size_t)a.ldk * 64 + voK); } \
    if constexpr (DQK == 192) { sr_[i].ks2 = *(const bf16x8*)((const char*)a.K2 + (size_t)rb_ * a.ldk2 * 2 + voK2); } } while (0)
#define SWRITE(b, i) do { *(bf16x8*)(V_lds + (b) * SHM_V + vst0) = sr_[i].vs0; *(bf16x8*)(V_lds + (b) * SHM_V + vst1) = sr_[i].vs1; \
    if constexpr (DQK == 64) { *(bf16x8*)(K_lds + (b) * SHM_K + kswz<DQK>(kr, kc * 2)) = sr_[i].ks0; } \
    else { *(bf16x8*)(K_lds + (b) * SHM_K + kswz<DQK>(sr, sc * 2)) = sr_[i].ks0; *(bf16x8*)(K_lds + (b) * SHM_K + kswz<DQK>(32 + sr, sc * 2)) = sr_[i].ks1; } \
    if constexpr (DQK == 192) { *(bf16x8*)(K_lds + (b) * SHM_K + kswz<DQK>(kr, (128 + kc) * 2)) = sr_[i].ks2; } } while (0)
#define SWAIT() do { if constexpr (SDEPTH == 2) asm volatile("s_waitcnt vmcnt(%0)" :: "n"(NLD) : "memory"); else asm volatile("s_waitcnt vmcnt(0)" ::: "memory"); } while (0)
#define RESC(al) do { if (__any((al) < 1.f)) { if (hi == 0) al_l[r32] = (al); asm volatile("s_waitcnt lgkmcnt(0)" ::: "memory"); \
    _Pragma("unroll") for (int d = 0; d < 4; ++d) _Pragma("unroll") for (int r = 0; r < 16; ++r) o[d][r] *= al_l[crow(r, hi)]; } } while (0)
#define MASK(P0, P1, j) do { if constexpr (MODE == 3) { if ((j) >= 4) { const int dq_ = a.kstart + ((j) - 4) * 64 - (a.q0 + wid * 32 + r32); \
    _Pragma("unroll") for (int r = 0; r < 16; ++r) { const int d0_ = dq_ + crow(r, hi), d1_ = d0_ + 32; \
      if (d0_ > 128 || d0_ < -128) P0[r] = -1e30f; if (d1_ > 128 || d1_ < -128) P1[r] = -1e30f; } } } } while (0)
  f32x16 pA0, pA1, pB0, pB1; float mnA, mnB, alA, alB; bf16x8 pa0, pa1, pa2, pa3; const int NT = a.NT;
  constexpr int SE = 0, SO = SDEPTH - 1;
  SLOAD(SE, 0); asm volatile("s_waitcnt vmcnt(0)" ::: "memory"); SWRITE(0, SE); __syncthreads();
  qkt<DQK>(pA0, pA1, K_lds, qr, r32, hi); MASK(pA0, pA1, 0); partialSM(pA0, pA1, m_reg, mnA, alA, C, thrs);
  SLOAD(SO, 1); if constexpr (SDEPTH == 2) { if (2 < NT) SLOAD(SE, 2); }
  SWAIT(); SWRITE(1, SO); __syncthreads();
  for (int j = 1; j + 1 < NT; j += 2) {
    SBAR(); qkt<DQK>(pB0, pB1, K_lds + SHM_K, qr, r32, hi); MASK(pB0, pB1, j);
    finishSM(pA0, pA1, alA, l_reg, pa0, pa1, pa2, pa3); SBAR();
    if constexpr (SDEPTH == 2) { SLOAD(SO, j + 2); } else { SLOAD(SE, j + 1); } SBAR();
    pv_d0(o, vb0, pa0, pa1, pa2, pa3); partialSM(pB0, pB1, m_reg, mnB, alB, C, thrs);
    __syncthreads(); SWAIT(); SWRITE(0, SE);
    RESC(alB); __syncthreads();
    SBAR(); qkt<DQK>(pA0, pA1, K_lds, qr, r32, hi); MASK(pA0, pA1, j + 1);
    finishSM(pB0, pB1, alB, l_reg, pa0, pa1, pa2, pa3); SBAR();
    if constexpr (SDEPTH == 2) { if (j + 3 < NT) SLOAD(SE, j + 3); } else { SLOAD(SO, j + 2); } SBAR();
    pv_d0(o, vb0 + (int)SHM_V, pa0, pa1, pa2, pa3); partialSM(pA0, pA1, m_reg, mnA, alA, C, thrs);
    __syncthreads(); SWAIT(); SWRITE(1, SO);
    RESC(alA); __syncthreads();
  }
  SBAR(); qkt<DQK>(pB0, pB1, K_lds + SHM_K, qr, r32, hi); MASK(pB0, pB1, NT - 1);
  finishSM(pA0, pA1, alA, l_reg, pa0, pa1, pa2, pa3); SBAR();
  pv_d0(o, vb0, pa0, pa1, pa2, pa3); partialSM(pB0, pB1, m_reg, mnB, alB, C, thrs);
  __syncthreads(); RESC(alB);
  finishSM(pB0, pB1, alB, l_reg, pa0, pa1, pa2, pa3); SBAR();
  pv_d0(o, vb0 + (int)SHM_V, pa0, pa1, pa2, pa3);
  if constexpr (MODE == 3) l_reg += __builtin_amdgcn_exp2f(a.sinkl2 - m_reg * C);
  if (hi == 0) li_l[r32] = l_reg; asm volatile("s_waitcnt lgkmcnt(0)" ::: "memory");
  float rli[16];
#pragma unroll
  for (int r = 0; r < 16; ++r) rli[r] = __builtin_amdgcn_rcpf(li_l[crow(r, hi)]);
  char* R = lds + 61440 + wid * 8704;
  if constexpr (MODE == 0 || MODE == 3) __syncthreads();
  if constexpr (MODE == 2) {
    float g[4];
#pragma unroll
    for (int d0 = 0; d0 < 4; ++d0) g[d0] = a.subln[d0 * 32 + r32] * a.postmul;
#pragma unroll
    for (int r = 0; r < 16; ++r) { char* Rr = R + crow(r, hi) * 272 + r32 * 2;
      float v[4], ss = 0.f;
#pragma unroll
      for (int d0 = 0; d0 < 4; ++d0) { const float o1 = __uint_as_float((unsigned)(*(const unsigned short*)(Rr + d0 * 64)) << 16); v[d0] = o1 - a.lam * (o[d0][r] * rli[r]); ss += v[d0] * v[d0]; }
      ss = half_sum32(ss, lane);
      const float rstd = rsqrtf(ss * (1.0f / 128.0f) + EPS);
#pragma unroll
      for (int d0 = 0; d0 < 4; ++d0) *(unsigned short*)(Rr + d0 * 64) = (unsigned short)(cvtpk(v[d0] * rstd * g[d0], 0.f) & 0xffffu); }
  } else {
#pragma unroll
    for (int r = 0; r < 16; ++r) { char* Rr = R + crow(r, hi) * 272 + r32 * 2;
#pragma unroll
      for (int d0 = 0; d0 < 4; ++d0) *(unsigned short*)(Rr + d0 * 64) = (unsigned short)(cvtpk(o[d0][r] * rli[r], 0.f) & 0xffffu); }
  }
  if constexpr (MODE != 1) {
    asm volatile("s_waitcnt lgkmcnt(0)" ::: "memory");
    bf16_t* Ow = a.O + (size_t)(wid * 32) * a.ldo;
#pragma unroll
    for (int i = 0; i < 8; ++i) { const int c = i * 64 + lane, row = c >> 4, cc = c & 15;
      const u32x4 w = *(const u32x4*)(R + row * 272 + cc * 16);
      *(u32x4*)(Ow + (size_t)row * a.ldo + cc * 8) = w; }
  }
  __syncthreads();
#undef KROW
#undef SLOAD
#undef SWRITE
#undef SWAIT
#undef RESC
#undef MASK
}

struct TJob { const float* src; const float* src2; bf16_t* dst; int K, Nsrc, Nd, mode; };
__device__ __forceinline__ TJob tjob(const Params& p, int l, int m) {
  char* W = p.ws + WS_W + (size_t)l * SZ_WL; TJob j; j.src2 = nullptr; j.mode = 0;
  switch (m) {
    case 0: j.src = p.in[10] + (size_t)l * DM * INC; j.dst = (bf16_t*)(W + OFF_WIN); j.K = DM; j.Nsrc = INC; j.Nd = LDP; break;
    case 1: j.src = p.in[20] + (size_t)l * 512 * 768; j.dst = (bf16_t*)(W + OFF_WUQ); j.K = 512; j.Nsrc = 768; j.Nd = 768; break;
    case 2: j.src = p.in[22] + (size_t)l * 256 * 1024; j.dst = (bf16_t*)(W + OFF_WUKV); j.K = 256; j.Nsrc = 1024; j.Nd = 1024; break;
    case 3: j.src = p.in[23] + (size_t)l * DM * DM; j.dst = (bf16_t*)(W + OFF_WOUT); j.K = DM; j.Nsrc = DM; j.Nd = DM; break;
    case 4: j.src = p.in[24] + (size_t)l * DM * DFF; j.src2 = p.in[25] + (size_t)l * DM * DFF; j.dst = (bf16_t*)(W + OFF_WGU); j.K = DM; j.Nsrc = DFF; j.Nd = 2 * DFF; j.mode = 1; break;
    default: j.src = p.in[26] + (size_t)l * DFF * DM; j.dst = (bf16_t*)(W + OFF_WDN); j.K = DFF; j.Nsrc = DM; j.Nd = DM; break;
  }
  return j;
}
__device__ __forceinline__ void ttile(const TJob& j, int tn, int tk, float* tl) {
  const int tid = otid(), k = tid >> 3, n8 = (tid & 7) * 8, n0 = tn * 64, k0 = tk * 256;
  const float* s = j.src; int scol = n0;
  if (j.mode == 1) { const int pn = n0 >> 8, r = n0 & 255; s = (r < 128) ? j.src : j.src2; scol = pn * 128 + (r & 127); }
  f32x4 va[4], vb[4];
  const bool nz = (j.mode == 1 || n0 < j.Nsrc);
#pragma unroll
  for (int kk = 0; kk < 4; ++kk) { va[kk] = (f32x4){0.f, 0.f, 0.f, 0.f}; vb[kk] = va[kk];
    if (nz) { const float* q = s + (size_t)(k0 + kk * 64 + k) * j.Nsrc + scol + n8; va[kk] = *(const f32x4*)q; vb[kk] = *(const f32x4*)(q + 4); } }
  __syncthreads();
#pragma unroll
  for (int kk = 0; kk < 4; ++kk)
#pragma unroll
    for (int i = 0; i < 4; ++i) { tl[(kk * 64 + k) * 65 + n8 + i] = va[kk][i]; tl[(kk * 64 + k) * 65 + n8 + 4 + i] = vb[kk][i]; }
  __syncthreads();
  const int n = tid >> 3, k8 = (tid & 7) * 8;
#pragma unroll
  for (int kk = 0; kk < 4; ++kk) {
    float v[8];
#pragma unroll
    for (int i = 0; i < 8; ++i) v[i] = tl[(kk * 64 + k8 + i) * 65 + n];
    u32x4 w = {cvtpk(v[0], v[1]), cvtpk(v[2], v[3]), cvtpk(v[4], v[5]), cvtpk(v[6], v[7])};
    *(u32x4*)(j.dst + (size_t)(n0 + n) * j.K + k0 + kk * 64 + k8) = w;
  }
}
__device__ __forceinline__ void phase0(const Params& p, char* lds) {
  const int tid = otid(), G = gridDim.x, bid = obid();
  float* tl = (float*)lds;
  int base = 0;
  for (int l = 0; l < 2; ++l)
    for (int m = 0; m < 6; ++m) {
      const TJob j = tjob(p, l, m); const int ntn = j.Nd / 64, ntk = j.K / 256, total = ntn * ntk;
      int first = (bid - (base % G) + G) % G;
      for (int t = first; t < total; t += G) ttile(j, t / ntk, t % ntk, tl);
      base += total;
    }
  __syncthreads();
  float* sv = (float*)lds;
  float* red = sv + 9 * DM;
  for (int i = tid; i < 9 * DM; i += 512) { const int r = i / DM, k = i % DM; const float c = (r < 8) ? p.in[1][r * DM + k] : p.in[3][k]; sv[i] = c / (1.0f + expf(-c)); }
  __syncthreads();
  float* mod = (float*)(p.ws + WS_MOD);
  for (int u = bid; u < 2 * 384; u += G) {
    const int l = u / 384, n0 = (u % 384) * 32, cl = tid & 7, sl = tid >> 3;
    const float* w = p.in[4] + (size_t)l * DM * 12288 + n0 + 4 * cl;
    f32x4 acc[9];
#pragma unroll
    for (int r = 0; r < 9; ++r) acc[r] = (f32x4){0.f, 0.f, 0.f, 0.f};
#pragma unroll 8
    for (int k = sl * 32; k < sl * 32 + 32; ++k) { const f32x4 wv = *(const f32x4*)(w + (size_t)k * 12288);
#pragma unroll
      for (int r = 0; r < 9; ++r) acc[r] += wv * sv[r * DM + k]; }
    const int lane = tid & 63;
#pragma unroll
    for (int r = 0; r < 9; ++r)
#pragma unroll
      for (int e = 0; e < 4; ++e) { float v = acc[r][e]; v += shflx(v, 8, lane); v += shflx(v, 16, lane); v += shflx(v, 32, lane); acc[r][e] = v; }
    if (lane < 8) {
#pragma unroll
      for (int r = 0; r < 9; ++r) *(f32x4*)(red + ((tid >> 6) * 9 + r) * 32 + 4 * lane) = acc[r];
    }
    __syncthreads();
    if (tid < 288) { const int r = tid >> 5, c2 = tid & 31; float t = 0.f;
#pragma unroll
      for (int s2 = 0; s2 < 8; ++s2) t += red[(s2 * 9 + r) * 32 + c2];
      mod[((size_t)l * 9 + r) * 12288 + n0 + c2] = t + p.in[5][(size_t)l * 12288 + n0 + c2]; }
    __syncthreads();
  }
  float* c128 = (float*)(p.ws + WS_ROPE); float* s128 = c128 + 4096 * 64; float* c64 = s128 + 4096 * 64; float* s64 = c64 + 4096 * 32;
  for (int i = bid * 512 + tid; i < 4096 * 64; i += G * 512) { const int t = i >> 6, a = i & 63; const float pos = (a < 32) ? (float)(t >> 6) : (float)(t & 63);
    const float inv = exp2f(-(float)(a & 31) * (13.287712379549449f / 32.0f)); const float ang = pos * inv; c128[i] = cosf(ang); s128[i] = sinf(ang); }
  for (int i = bid * 512 + tid; i < 4096 * 32; i += G * 512) { const int t = i >> 5, a = i & 31; const float pos = (a < 16) ? (float)(t >> 6) : (float)(t & 63);
    const float inv = exp2f(-(float)(a & 15) * (13.287712379549449f / 16.0f)); const float ang = pos * inv; c64[i] = cosf(ang); s64[i] = sinf(ang); }
  if (bid == 0 && tid < 128) {
    const int l = tid >> 6, i = tid & 63;
    float a1 = p.in[13][l * 64 + i] * p.in[14][l * 64 + i], a2 = p.in[15][l * 64 + i] * p.in[16][l * 64 + i];
    a1 = wave_sum64(a1, tid & 63); a2 = wave_sum64(a2, tid & 63);
    if (i == 0) ((float*)(p.ws + WS_MISC))[l] = expf(a1) - expf(a2) + p.lam_init[l];
  }
}

struct RowArgs {
  const float* xlat_in; const float* xctx_in; float* xlat_out; float* xctx_out;
  const bf16_t* xlat_in16; bf16_t* xlat_out16;
  const bf16_t* Y; const float* gpost; const float* gate;
  bf16_t* H; const float* gnext; const float* shift; const float* scale;
  int M;
  int r0, vb, vG;
};
__device__ __forceinline__ void row_phase(const RowArgs& a) {
  const int tid_ = otid(), lane = tid_ & 63, gw = a.r0 + a.vb * 8 + (tid_ >> 6), nw = a.vG * 8;
  f32x4 x[8], xn[8]; u32x2 yw[8], ywn[8], xw[8], xwn[8];
#define ROW_LOAD(X, XW, YW, r_) do { const bool lat_ = (r_) < NLAT; const float* xin_ = lat_ ? a.xlat_in + (size_t)(r_) * DM : a.xctx_in + (size_t)((r_) - NLAT) * DM; \
    if (lat_ && a.xlat_in16) { _Pragma("unroll") for (int i = 0; i < 8; ++i) XW[i] = *(const u32x2*)(a.xlat_in16 + (size_t)(r_) * DM + (i * 64 + lane) * 4); } \
    else { _Pragma("unroll") for (int i = 0; i < 8; ++i) X[i] = *(const f32x4*)(xin_ + (i * 64 + lane) * 4); } \
    if (a.Y) { _Pragma("unroll") for (int i = 0; i < 8; ++i) YW[i] = *(const u32x2*)(a.Y + (size_t)(r_) * DM + (i * 64 + lane) * 4); } } while (0)
  if (gw < a.M) ROW_LOAD(x, xw, yw, gw);
  for (int row = gw; row < a.M; row += nw) {
    const bool lat = row < NLAT; const int bi = lat ? (row >> 12) : 8;
    float* xout = lat ? a.xlat_out + (size_t)row * DM : a.xctx_out + (size_t)(row - NLAT) * DM;
    const int rnext = row + nw;
    if (rnext < a.M) ROW_LOAD(xn, xwn, ywn, rnext);
    if (lat && a.xlat_in16) {
#pragma unroll
      for (int i = 0; i < 8; ++i) x[i] = (f32x4){bflo(xw[i].x), bfhi(xw[i].x), bflo(xw[i].y), bfhi(xw[i].y)};
    }
    if (a.Y) {
      f32x4 y[8]; float ss = 0.f;
#pragma unroll
      for (int i = 0; i < 8; ++i) { const u32x2 w = yw[i];
        y[i] = (f32x4){bflo(w.x), bfhi(w.x), bflo(w.y), bfhi(w.y)}; ss += y[i][0] * y[i][0] + y[i][1] * y[i][1] + y[i][2] * y[i][2] + y[i][3] * y[i][3]; }
      ss = wave_sum64(ss, lane); const float rstd = rsqrtf(ss * (1.0f / DM) + EPS);
      const float* gt = a.gate + (size_t)bi * 12288;
#pragma unroll
      for (int i = 0; i < 8; ++i) { const int c = (i * 64 + lane) * 4; const f32x4 gp = *(const f32x4*)(a.gpost + c), gg = *(const f32x4*)(gt + c);
        x[i] = x[i] + gg * (y[i] * rstd * gp);
        if (lat && a.xlat_out16) { u32x2 w; w.x = cvtpk(x[i][0], x[i][1]); w.y = cvtpk(x[i][2], x[i][3]); *(u32x2*)(a.xlat_out16 + (size_t)row * DM + c) = w; }
        else *(f32x4*)(xout + c) = x[i]; }
    }
    if (a.H) {
      float ss = 0.f;
#pragma unroll
      for (int i = 0; i < 8; ++i) ss += x[i][0] * x[i][0] + x[i][1] * x[i][1] + x[i][2] * x[i][2] + x[i][3] * x[i][3];
      ss = wave_sum64(ss, lane); const float rstd = rsqrtf(ss * (1.0f / DM) + EPS);
      const float* sh = a.shift + (size_t)bi * 12288; const float* sc = a.scale + (size_t)bi * 12288;
#pragma unroll
      for (int i = 0; i < 8; ++i) { const int c = (i * 64 + lane) * 4; const f32x4 gn = *(const f32x4*)(a.gnext + c), s1 = *(const f32x4*)(sh + c), s2 = *(const f32x4*)(sc + c);
        const f32x4 h = (x[i] * rstd * gn) * (s2 + 1.0f) + s1;
        u32x2 w; w.x = cvtpk(h[0], h[1]); w.y = cvtpk(h[2], h[3]); *(u32x2*)(a.H + (size_t)row * DM + c) = w; }
    }
#pragma unroll
    for (int i = 0; i < 8; ++i) { x[i] = xn[i]; yw[i] = ywn[i]; xw[i] = xwn[i]; }
  }
#undef ROW_LOAD
}

__device__ __forceinline__ void unpack8(const u32x4 w, float (&f)[8]) { f[0] = bflo(w.x); f[1] = bfhi(w.x); f[2] = bflo(w.y); f[3] = bfhi(w.y); f[4] = bflo(w.z); f[5] = bfhi(w.z); f[6] = bflo(w.w); f[7] = bfhi(w.w); }
__device__ __forceinline__ u32x4 pack8(const float (&f)[8]) { u32x4 w; w.x = cvtpk(f[0], f[1]); w.y = cvtpk(f[2], f[3]); w.z = cvtpk(f[4], f[5]); w.w = cvtpk(f[6], f[7]); return w; }
__device__ __forceinline__ void ld8f(const float* p, float (&f)[8]) { const f32x4 a = *(const f32x4*)p, b = *(const f32x4*)(p + 4); f[0] = a[0]; f[1] = a[1]; f[2] = a[2]; f[3] = a[3]; f[4] = b[0]; f[5] = b[1]; f[6] = b[2]; f[7] = b[3]; }
struct PrepRow { u32x4 ha, hb, ga, gb, q, kv; };
__device__ __forceinline__ void prep_phase(const Params& p, int l) {
  char* wsb = wsp(p);
  bf16_t* P = (bf16_t*)(wsb + WS_P);
  const float* kg = p.in[12] + l * 128; const float* qn = p.in[19] + l * 512; const float* kvn = p.in[21] + l * 256;
  const float* c128 = (const float*)(wsb + WS_ROPE); const float* s128 = c128 + 4096 * 64; const float* c64 = s128 + 4096 * 64; const float* s64 = c64 + 4096 * 32;
  const int tid_ = otid(), lane = tid_ & 63, gw = obid() * 8 + (tid_ >> 6), nw = gridDim.x * 8;
  const int hidx = lane >> 3, hj = lane & 7, gj = lane & 3, l2 = lane & 31;
  const int hcol = (hidx < 2 ? C_GK + hidx * 128 : C_WK + ((hidx - 2) & 1) * 128) + 8 * hj;
  const int gcol = (lane < 32 ? C_DK + (lane >> 2) * 64 : C_MKR) + 8 * gj;
#define PREP_LOAD(D, r_) do { const bool lat_ = (r_) < NLAT; const bf16_t* pr_ = P + (size_t)(r_) * LDP; const u32x4 z_ = {0u, 0u, 0u, 0u}; \
    const bool hact_ = hidx < 4 && (lat_ || hidx < 2), gact_ = lat_ && lane < 36; \
    D.ha = z_; D.hb = z_; D.ga = z_; D.gb = z_; D.kv = z_; \
    if (hact_) { D.ha = *(const u32x4*)(pr_ + hcol); D.hb = *(const u32x4*)(pr_ + hcol + 64); } \
    if (gact_) { D.ga = *(const u32x4*)(pr_ + gcol); D.gb = *(const u32x4*)(pr_ + gcol + 32); } \
    D.q = *(const u32x4*)(pr_ + C_MQ + 8 * lane); if (lane < 32) D.kv = *(const u32x4*)(pr_ + C_MKV + 8 * l2); } while (0)
  PrepRow cur, nxt;
  if (gw < NROWS) PREP_LOAD(cur, gw);
  for (int row = gw; row < NROWS; row += nw) {
    const bool lat = row < NLAT; const int t = row & 4095;
    bf16_t* pr = P + (size_t)row * LDP;
    const bool hact = hidx < 4 && (lat || hidx < 2), gact = lat && lane < 36;
    if (row + nw < NROWS) PREP_LOAD(nxt, row + nw);
    { float xa[8], xb[8]; unpack8(cur.ha, xa); unpack8(cur.hb, xb);
      float ss = 0.f;
#pragma unroll
      for (int e = 0; e < 8; ++e) ss += xa[e] * xa[e] + xb[e] * xb[e];
      ss += shflx(ss, 1, lane); ss += shflx(ss, 2, lane); ss += shflx(ss, 4, lane);
      if (hidx < 2) {
        const float rstd = rsqrtf(ss * (1.0f / 128.0f) + EPS);
        float ga[8], gb[8]; ld8f(kg + 8 * hj, ga); ld8f(kg + 64 + 8 * hj, gb);
#pragma unroll
        for (int e = 0; e < 8; ++e) { xa[e] *= rstd * ga[e]; xb[e] *= rstd * gb[e]; }
      }
      if (lat) {
        float c[8], sn[8]; ld8f(c128 + t * 64 + 8 * hj, c); ld8f(s128 + t * 64 + 8 * hj, sn);
#pragma unroll
        for (int e = 0; e < 8; ++e) { const float a0 = xa[e] * c[e] - xb[e] * sn[e], b0 = xb[e] * c[e] + xa[e] * sn[e]; xa[e] = a0; xb[e] = b0; }
      }
      if (hact) { *(u32x4*)(pr + hcol) = pack8(xa); *(u32x4*)(pr + hcol + 64) = pack8(xb); }
    }
    if (gact) {
      float c[8], sn[8]; ld8f(c64 + t * 32 + 8 * gj, c); ld8f(s64 + t * 32 + 8 * gj, sn);
      float xa[8], xb[8]; unpack8(cur.ga, xa); unpack8(cur.gb, xb);
#pragma unroll
      for (int e = 0; e < 8; ++e) { const float a0 = xa[e] * c[e] - xb[e] * sn[e], b0 = xb[e] * c[e] + xa[e] * sn[e]; xa[e] = a0; xb[e] = b0; }
      *(u32x4*)(pr + gcol) = pack8(xa); *(u32x4*)(pr + gcol + 32) = pack8(xb);
    }
    { float x[8]; unpack8(cur.q, x);
      float ss = 0.f;
#pragma unroll
      for (int e = 0; e < 8; ++e) ss += x[e] * x[e];
      ss = wave_sum64(ss, lane); const float rstd = rsqrtf(ss * (1.0f / 512.0f) + EPS);
      float g[8]; ld8f(qn + 8 * lane, g);
#pragma unroll
      for (int e = 0; e < 8; ++e) x[e] *= rstd * g[e];
      *(u32x4*)(pr + C_MQ + 8 * lane) = pack8(x);
      unpack8(cur.kv, x); float s2 = 0.f;
#pragma unroll
      for (int e = 0; e < 8; ++e) s2 += x[e] * x[e];
      s2 = wave_sum64(s2, lane); const float rstd2 = rsqrtf(s2 * (1.0f / 256.0f) + EPS);
      ld8f(kvn + 8 * l2, g);
#pragma unroll
      for (int e = 0; e < 8; ++e) x[e] *= rstd2 * g[e];
      if (lane < 32) *(u32x4*)(pr + C_MKV + 8 * l2) = pack8(x);
    }
    cur = nxt;
  }
#undef PREP_LOAD
}

__device__ __forceinline__ void attn_phase(const Params& p, int l, bool ctx_out, char* lds) {
  char* wsb = wsp(p);
  const bf16_t* P = (const bf16_t*)(wsb + WS_P); const bf16_t* QM = (const bf16_t*)(wsb + WS_QM); const bf16_t* KVM = (const bf16_t*)(wsb + WS_KVM);
  bf16_t* ATT = (bf16_t*)(wsb + WS_ATT);
  const float* c128 = (const float*)(wsb + WS_ROPE); const float* s128 = c128 + 4096 * 64;
  const float* c64 = (const float*)(wsb + WS_ROPE) + 2 * 4096 * 64; const float* s64 = c64 + 4096 * 32;
  const float lam = ((const float*)(wsb + WS_MISC))[l];
  const float L2E = 1.4426950408889634f;
  const int bid_ = obid();
  for (int v = bid_; v < 256; v += gridDim.x) {
    const int b = v & 7, j = v >> 3, hsel = j >> 4, qb = j & 15;
    const int nun = 8 + ((ctx_out && j < 16) ? 1 : 0);
    for (int u = 0; u < nun; ++u) {
      int type, head, qrow0, NT; bool isctx = (u == 8);
      if (!isctx) { type = u >> 1; head = (u & 1) * 2 + hsel; qrow0 = b * SEQ + qb * 256; NT = 68; }
      else { type = j >> 2; head = j & 3; qrow0 = NLAT + b * CTXL; NT = 4; }
      AttnArgs a;
      a.crow0 = NLAT + b * CTXL; a.lrow0 = b * SEQ; a.NT = NT; a.ldo = DM; a.tmp = (float*)(wsb + WS_TMP) + (size_t)bid_ * 256 * 128;
      a.lam = lam; a.postmul = p.one_minus_lam_init[l]; a.subln = p.in[17] + l * 128; a.sinkl2 = 0.f; a.q0 = 0; a.kstart = 0; a.rc = c64; a.rs = s64; a.tq0 = isctx ? -1 : qb * 256; a.qgain = p.in[11] + l * 128;
      a.K2 = nullptr; a.ldk2 = 0;
      if (type == 0) {
        const int g = head >> 1; const float sc = 0.08838834764831845f;
        a.Q = P + (size_t)qrow0 * LDP + C_GQ + head * 128; a.ldq = LDP; a.K = P + C_GK + g * 128; a.ldk = LDP; a.V = P + C_GV + g * 128; a.ldv = LDP;
        a.C = sc * L2E; a.thrs = 8.f / sc; a.O = ATT + (size_t)qrow0 * DM + head * 128; a.rc = c128; a.rs = s128;
        attn_unit<128, 0, 2, 1>(a, lds);
      } else if (type == 1) {
        const float sc = 0.125f;
        a.Q = P + (size_t)qrow0 * LDP + C_DQ + head * 128; a.ldq = LDP; a.K = P + C_DK + head * 128; a.ldk = LDP; a.V = P + C_DV + head * 128; a.ldv = LDP;
        a.C = sc * L2E; a.thrs = 8.f / sc; a.O = ATT + (size_t)qrow0 * DM + 512 + head * 128;
        attn_unit<64, 1, 2, 2>(a, lds);
        a.Q += 64; a.K += 64;
        attn_unit<64, 2, 2, 2>(a, lds);
      } else if (type == 2) {
        const int g = head >> 1; const float sc = 0.08838834764831845f;
        a.Q = P + (size_t)qrow0 * LDP + C_WQ + head * 128; a.ldq = LDP; a.K = P + C_WK + g * 128; a.ldk = LDP; a.V = P + C_WV + g * 128; a.ldv = LDP;
        a.C = sc * L2E; a.thrs = 8.f / sc; a.O = ATT + (size_t)qrow0 * DM + 1024 + head * 128;
        a.sinkl2 = p.in[18][l * 4 + head] * L2E; a.rc = c128; a.rs = s128;
        if (!isctx) { const int q0 = qb * 256; const int ks = (qb == 0) ? 0 : q0 - 128; const int ke = (qb == 15) ? SEQ : q0 + 384;
          a.q0 = __builtin_amdgcn_readfirstlane(q0); a.kstart = __builtin_amdgcn_readfirstlane(ks); a.lrow0 = __builtin_amdgcn_readfirstlane(b * SEQ + ks); a.NT = __builtin_amdgcn_readfirstlane(4 + (ke - ks) / 64); }
        attn_unit<128, 3, 2, 2>(a, lds);
      } else {
        const float sc = 0.07216878364870322f;
        a.Q = QM + (size_t)qrow0 * LDQM + head * 192; a.ldq = LDQM; a.K = KVM + head * 256; a.ldk = LDKVM; a.K2 = P + C_MKR; a.ldk2 = LDP; a.V = KVM + head * 256 + 128; a.ldv = LDKVM;
        a.C = sc * L2E; a.thrs = 8.f / sc; a.O = ATT + (size_t)qrow0 * DM + 1536 + head * 128;
        attn_unit<192, 0, 1, 2>(a, lds);
      }
    }
  }
}

__device__ __forceinline__ char* wsp(const Params& p) { char* w = p.ws; asm volatile("" : "+s"(w)); return w; }
__global__ void __launch_bounds__(512) fwd_megakernel(Params p) {
  extern __shared__ __attribute__((aligned(16))) char shm[];
  cg::grid_group grid = cg::this_grid();
  LAS unsigned char* ldsg = (LAS unsigned char*)shm;
  volatile LAS unsigned* xst = (volatile LAS unsigned*)(ldsg + pg8::STAGE_BYTES);
  if (threadIdx.x == 0) { xst[0] = 0u; xst[1] = 0u; }
  __syncthreads();
  const XcdBarrier xbar = xcd_barrier_post((unsigned*)(p.ws + WS_BAR), xst);
  phase0(p, shm);
  grid.sync();
  { char* ws = wsp(p); const float* mod = (const float*)(ws + WS_MOD);
    RowArgs a; a.xlat_in = p.in[0]; a.xctx_in = p.in[2]; a.xlat_out = p.out; a.xctx_out = (float*)(ws + WS_XC); a.xlat_in16 = nullptr; a.xlat_out16 = nullptr; a.Y = nullptr; a.gpost = nullptr; a.gate = nullptr;
    a.H = (bf16_t*)(ws + WS_H); a.gnext = p.in[6]; a.shift = mod + 0 * DM; a.scale = mod + 1 * DM; a.M = NROWS; a.r0 = 0; a.vb = obid(); a.vG = gridDim.x; row_phase(a); }
  xcd_barrier(xbar);
  for (int l0 = 0; l0 < 2; ++l0) {
    int l = l0; asm volatile("" : "+s"(l));
    const bool last = (l == 1);
    const int Mr = last ? NLAT : NROWS;
    { char* ws = wsp(p); pg8::StaticOrder S; pg8::Gemm g{(const bf16_t*)(ws + WS_H), (const bf16_t*)(ws + WS_W + (size_t)l * SZ_WL + OFF_WIN), NROWS, LDP, DM, DM};
      S.init(g.M, g.N, gridDim.x, obid()); pg8::EpiBf16 e{(bf16_t*)(ws + WS_P), LDP}; pg8::gemm_phase(ldsg, g, S, e); }
    xcd_barrier(xbar);
    prep_phase(p, l);
    xcd_barrier(xbar);
    { char* ws = wsp(p); pg8::StaticOrder S; pg8::Gemm g{(const bf16_t*)(ws + WS_P) + C_MQ, (const bf16_t*)(ws + WS_W + (size_t)l * SZ_WL + OFF_WUQ), NROWS, 768, 512, LDP};
      S.init(g.M, g.N, gridDim.x, obid()); pg8::EpiBf16 e{(bf16_t*)(ws + WS_QM), LDQM}; pg8::gemm_phase(ldsg, g, S, e); }
    { char* ws = wsp(p); pg8::StaticOrder S; pg8::Gemm g{(const bf16_t*)(ws + WS_P) + C_MKV, (const bf16_t*)(ws + WS_W + (size_t)l * SZ_WL + OFF_WUKV), NROWS, 1024, 256, LDP};
      S.init(g.M, g.N, gridDim.x, obid()); pg8::EpiBf16 e{(bf16_t*)(ws + WS_KVM), LDKVM}; pg8::gemm_phase(ldsg, g, S, e); }
    xcd_barrier(xbar);
    attn_phase(p, l, !last, shm);
    xcd_barrier(xbar);
    const bool cx = !last; const int bid = obid(), G = gridDim.x;
    { char* ws = wsp(p); pg8::StaticOrder S; pg8::Gemm g{(const bf16_t*)(ws + WS_ATT), (const bf16_t*)(ws + WS_W + (size_t)l * SZ_WL + OFF_WOUT), NLAT, DM, DM, DM};
      S.init(g.M, g.N, G, bid); pg8::EpiBf16 e{(bf16_t*)(ws + WS_Y), DM}; pg8::gemm_phase(ldsg, g, S, e); }
    xcd_barrier(xbar);
    if (cx && bid < 64) {
      char* ws = wsp(p); pg8::StaticOrder S; pg8::Gemm g{(const bf16_t*)(ws + WS_ATT) + (size_t)NLAT * DM, (const bf16_t*)(ws + WS_W + (size_t)l * SZ_WL + OFF_WOUT), NCTX, DM, DM, DM};
      S.init(g.M, g.N, 64, bid); pg8::EpiBf16 e{(bf16_t*)(ws + WS_Y) + (size_t)NLAT * DM, DM}; pg8::gemm_phase(ldsg, g, S, e);
    } else {
      {
        char* ws = wsp(p); const float* modl = (const float*)(ws + WS_MOD) + (size_t)l * 9 * 12288;
        RowArgs a; a.xlat_in = p.in[0]; a.xctx_in = (l == 0) ? p.in[2] : (const float*)(ws + WS_XC); a.xlat_out = p.out; a.xctx_out = (float*)(ws + WS_XC);
        a.xlat_in16 = (l == 0) ? nullptr : (const bf16_t*)p.out; a.xlat_out16 = (bf16_t*)(ws + WS_ATT);
        a.Y = (const bf16_t*)(ws + WS_Y); a.gpost = p.in[7] + l * DM; a.gate = modl + 2 * DM;
        a.H = (bf16_t*)(ws + WS_H); a.gnext = p.in[8] + l * DM; a.shift = modl + 3 * DM; a.scale = modl + 4 * DM;
        a.r0 = 0; a.M = NLAT; a.vb = cx ? bid - 64 : bid; a.vG = cx ? G - 64 : G; row_phase(a);
      }
    }
    xcd_barrier(xbar);
    if (cx) {
      char* ws = wsp(p); const float* modl = (const float*)(ws + WS_MOD) + (size_t)l * 9 * 12288;
      RowArgs a; a.xlat_in = p.in[0]; a.xctx_in = p.in[2]; a.xlat_out = p.out; a.xctx_out = (float*)(ws + WS_XC); a.xlat_in16 = nullptr; a.xlat_out16 = nullptr;
      a.Y = (const bf16_t*)(ws + WS_Y); a.gpost = p.in[7] + l * DM; a.gate = modl + 2 * DM;
      a.H = (bf16_t*)(ws + WS_H); a.gnext = p.in[8] + l * DM; a.shift = modl + 3 * DM; a.scale = modl + 4 * DM;
      a.r0 = NLAT; a.M = NROWS; a.vb = bid; a.vG = G; row_phase(a);
      xcd_barrier(xbar);
    }
    { char* ws = wsp(p); pg8::StaticOrder S; pg8::Gemm g{(const bf16_t*)(ws + WS_H), (const bf16_t*)(ws + WS_W + (size_t)l * SZ_WL + OFF_WGU), Mr, 2 * DFF, DM, DM};
      S.init(g.M, g.N, G, bid); pg8::EpiSwiGLU e{(bf16_t*)(ws + WS_U), DFF}; pg8::gemm_phase(ldsg, g, S, e); }
    xcd_barrier(xbar);
    { char* ws = wsp(p); pg8::StaticOrder S; pg8::Gemm g{(const bf16_t*)(ws + WS_U), (const bf16_t*)(ws + WS_W + (size_t)l * SZ_WL + OFF_WDN), NLAT, DM, DFF, DFF};
      S.init(g.M, g.N, G, bid); pg8::EpiBf16 e{(bf16_t*)(ws + WS_H), DM}; pg8::gemm_phase(ldsg, g, S, e); }
    xcd_barrier(xbar);
    if (cx && bid < 64) {
      char* ws = wsp(p); pg8::StaticOrder S; pg8::Gemm g{(const bf16_t*)(ws + WS_U) + (size_t)NLAT * DFF, (const bf16_t*)(ws + WS_W + (size_t)l * SZ_WL + OFF_WDN), NCTX, DM, DFF, DFF};
      S.init(g.M, g.N, 64, bid); pg8::EpiBf16 e{(bf16_t*)(ws + WS_H) + (size_t)NLAT * DM, DM}; pg8::gemm_phase(ldsg, g, S, e);
    } else {
      char* ws = wsp(p); const float* modl = (const float*)(ws + WS_MOD) + (size_t)l * 9 * 12288;
      RowArgs a; a.xlat_in = p.out; a.xctx_in = (const float*)(ws + WS_XC); a.xlat_out = p.out; a.xctx_out = (float*)(ws + WS_XC);
      a.xlat_in16 = (const bf16_t*)(ws + WS_ATT); a.xlat_out16 = last ? nullptr : (bf16_t*)p.out;
      a.Y = (const bf16_t*)(ws + WS_H); a.gpost = p.in[9] + l * DM; a.gate = modl + 5 * DM;
      a.H = last ? nullptr : (bf16_t*)(ws + WS_H); a.gnext = last ? nullptr : p.in[6] + (l + 1) * DM;
      a.shift = last ? nullptr : modl + 9 * 12288 + 0 * DM; a.scale = last ? nullptr : modl + 9 * 12288 + 1 * DM;
      a.r0 = 0; a.M = NLAT; a.vb = cx ? bid - 64 : bid; a.vG = cx ? G - 64 : G; row_phase(a);
    }
    if (cx) {
      xcd_barrier(xbar);
      char* ws = wsp(p); const float* modl = (const float*)(ws + WS_MOD) + (size_t)l * 9 * 12288;
      RowArgs a; a.xlat_in = p.out; a.xctx_in = (const float*)(ws + WS_XC); a.xlat_out = p.out; a.xctx_out = (float*)(ws + WS_XC); a.xlat_in16 = nullptr; a.xlat_out16 = nullptr;
      a.Y = (const bf16_t*)(ws + WS_H); a.gpost = p.in[9] + l * DM; a.gate = modl + 5 * DM;
      a.H = (bf16_t*)(ws + WS_H); a.gnext = p.in[6] + (l + 1) * DM; a.shift = modl + 9 * 12288 + 0 * DM; a.scale = modl + 9 * 12288 + 1 * DM;
      a.r0 = NLAT; a.M = NROWS; a.vb = bid; a.vG = G; row_phase(a);
    }
    if (!last) xcd_barrier(xbar);
  }
}

extern "C" void kernel_launch(void* const* d_in, const int* in_sizes, int n_in, void* d_out, int out_size, void* d_ws, size_t ws_size, hipStream_t stream) {
  constexpr size_t kDynLds = pg8::STAGE_BYTES + 64;
  static int ready = 0;
  if (!ready) {
    if (n_in != 27 || ws_size < WS_END) { fprintf(stderr, "kernel_launch: unexpected n_in %d / ws_size %zu (need %zu)\n", n_in, ws_size, (size_t)WS_END); return; }
    if (hipFuncSetAttribute((const void*)fwd_megakernel, hipFuncAttributeMaxDynamicSharedMemorySize, (int)kDynLds) != hipSuccess) { fprintf(stderr, "kernel_launch: LDS attribute failed\n"); return; }
    ready = 1;
  }
  Params p{};
  for (int i = 0; i < 27; ++i) p.in[i] = (const float*)d_in[i];
  p.out = (float*)d_out; p.ws = (char*)d_ws;
  for (int l = 0; l < 2; ++l) { const float li = (float)(0.8 - 0.6 * exp(-0.3 * (double)l)); p.lam_init[l] = li; p.one_minus_lam_init[l] = 1.0f - li; }
  if (hipMemsetAsync((char*)d_ws + WS_BAR, 0, 16384, stream) != hipSuccess) { fprintf(stderr, "kernel_launch: memset of barrier words failed\n"); return; }
  void* args[] = {&p};
  hipError_t e = hipLaunchCooperativeKernel((void*)fwd_megakernel, dim3(256), dim3(512), args, kDynLds, stream);
  if (e != hipSuccess) fprintf(stderr, "cooperative launch failed: %s\n", hipGetErrorString(e));
}
```
